# Optimizing an MI355X kernel written in HIP

```python
import math
import jax, jax.numpy as jnp
from jax import lax
import numpy as np

D_MODEL = 2048
BATCH = 2
SEQ = 16384
DEPTH = 1
DEC_BATCH = 32
DEC_SEQ = 16
PAST_LEN = 1024

CHUNK = 64
QBLK = 128
DIFF_WIDTH = D_MODEL // 2
DIFF_H = 8
DIFF_DH = DIFF_WIDTH // DIFF_H // 2
CONV_W = D_MODEL // 4
CONV_K = 3
MEM_WIDTH = D_MODEL // 4
MEM_H = 4
MEM_DH = MEM_WIDTH // MEM_H
N_MEM = 256
N_BUCKETS = 32
MAX_DISTANCE = 128
MIX_WIDTH = DIFF_WIDTH + CONV_W + MEM_WIDTH
ALPHA = (2 * DEPTH) ** 0.25
BETA = (8 * DEPTH) ** -0.25
EPS = 1e-5

PROJ_WIDTHS = (2 * DIFF_WIDTH // 2 * 1, DIFF_WIDTH, DIFF_WIDTH, CONV_W, CONV_W, CONV_W, MEM_WIDTH,
               DIFF_WIDTH, CONV_W, MEM_WIDTH)
PROJ_TOTAL = sum(PROJ_WIDTHS)
PROJ_SPLITS = tuple(int(s) for s in np.cumsum(PROJ_WIDTHS)[:-1])

kernel_name = "hybrid_diffattn_shortconv_mem_stream_step"


def layer_norm(x, g, b):
    xf = x.astype(jnp.float32)
    mu = jnp.mean(xf, axis=-1, keepdims=True)
    var = jnp.mean(jnp.square(xf - mu), axis=-1, keepdims=True)
    return ((xf - mu) * lax.rsqrt(var + EPS) * g.astype(jnp.float32) + b.astype(jnp.float32)).astype(x.dtype)


def rms_norm(x, g):
    xf = x.astype(jnp.float32)
    y = xf * lax.rsqrt(jnp.mean(jnp.square(xf), axis=-1, keepdims=True) + EPS)
    return (y * g.astype(jnp.float32)).astype(x.dtype)


def t5_bucket(rel):
    half = N_BUCKETS // 2
    max_exact = half // 2
    ret = jnp.where(rel > 0, half, 0)
    n = jnp.abs(rel)
    nf = jnp.maximum(n, 1).astype(jnp.float32)
    large = max_exact + (jnp.log(nf / max_exact) / math.log(MAX_DISTANCE / max_exact)
                         * (half - max_exact)).astype(jnp.int32)
    large = jnp.minimum(large, half - 1)
    return ret + jnp.where(n < max_exact, n, large)


def rel_bias(qpos, kpos, table):
    bucket = t5_bucket(kpos[None, :] - qpos[:, None])
    return jnp.transpose(jnp.take(table, bucket, axis=0), (2, 0, 1))


def chunk_mask(qpos, kpos):
    return (kpos[None, :] // CHUNK) <= (qpos[:, None] // CHUNK)


def diff_attention(q, k, v, bias, mask, lam):
    s = jnp.einsum('bqhcd,bkhcd->bchqk', q, k).astype(jnp.float32) * (DIFF_DH ** -0.5)
    s = s + bias.astype(jnp.float32)
    s = jnp.where(mask, s, -jnp.inf)
    p = jax.nn.softmax(s, axis=-1)
    a = p[:, 0] - lam * p[:, 1]
    return jnp.einsum('bhqk,bkhe->bqhe', a.astype(v.dtype), v)


def prompt_diff_attention(q, k, v, lam, table):
    b, s = q.shape[0], q.shape[1]
    nb = s // QBLK
    qb = q.reshape(b, nb, QBLK, DIFF_H, 2, DIFF_DH).swapaxes(0, 1)
    kpos = jnp.arange(s)

    def block(args):
        qi, i = args
        qpos = i * QBLK + jnp.arange(QBLK)
        return diff_attention(qi, k, v, rel_bias(qpos, kpos, table), chunk_mask(qpos, kpos), lam)

    o = lax.map(block, (qb, jnp.arange(nb)))
    return o.swapaxes(0, 1).reshape(b, s, DIFF_H, 2 * DIFF_DH)


def mem_attention(q, mk, mv):
    s = jnp.einsum('bqhd,bkhd->bhqk', q, mk).astype(jnp.float32) * (MEM_DH ** -0.5)
    p = jax.nn.softmax(s, axis=-1)
    o = jnp.einsum('bhqk,bkhd->bqhd', p.astype(mv.dtype), mv)
    return o.reshape(q.shape[0], q.shape[1], MEM_WIDTH)


def causal_conv(u_padded, w, s):
    y = w[0] * u_padded[:, 0:s]
    for j in range(1, CONV_K):
        y = y + w[j] * u_padded[:, j:j + s]
    return y


def in_projection(x, w_in):
    p = jnp.einsum('bsd,de->bse', x, w_in)
    q, k, v, h, bg, cg, mq, g_d, g_c, g_m = jnp.split(p, PROJ_SPLITS, axis=-1)
    b, s = x.shape[0], x.shape[1]
    q = q.reshape(b, s, DIFF_H, 2, DIFF_DH)
    k = k.reshape(b, s, DIFF_H, 2, DIFF_DH)
    v = v.reshape(b, s, DIFF_H, 2 * DIFF_DH)
    mq = mq.reshape(b, s, MEM_H, MEM_DH)
    return q, k, v, h, bg, cg, mq, g_d, g_c, g_m


def diff_lambda(lq1, lk1, lq2, lk2, lam_init):
    f = jnp.float32
    return (jnp.exp(jnp.sum(lq1.astype(f) * lk1.astype(f))) -
            jnp.exp(jnp.sum(lq2.astype(f) * lk2.astype(f))) + lam_init)


def merge_and_norm(x, o_diff, conv_y, o_mem, g_d, g_c, g_m, subln_g, lam_init, w_out, ln_g, ln_b):
    b, s = x.shape[0], x.shape[1]
    o_diff = (rms_norm(o_diff, subln_g) * (1.0 - lam_init)).reshape(b, s, DIFF_WIDTH)
    z = jnp.concatenate([o_diff * jax.nn.silu(g_d),
                         conv_y * jax.nn.silu(g_c),
                         o_mem * jax.nn.silu(g_m)], axis=-1)
    o = jnp.einsum('bse,ed->bsd', z, w_out)
    return layer_norm(ALPHA * x + o, ln_g, ln_b)


def setup_inputs(seed: int = 0) -> dict:
    key = jax.random.key(seed)
    ks = jax.random.split(key, 20)
    f = jnp.float32

    def nrm(k, shape, s):
        return jax.random.normal(k, shape, f) * s

    return {
        "x_prompt": nrm(ks[0], (BATCH, SEQ, D_MODEL), 1.0),
        "x_sample": nrm(ks[1], (DEC_BATCH, DEC_SEQ, D_MODEL), 1.0),
        "cache_diff_k": nrm(ks[2], (DEPTH, DEC_BATCH, PAST_LEN, DIFF_H, 2 * DIFF_DH), 1.0),
        "cache_diff_v": nrm(ks[3], (DEPTH, DEC_BATCH, PAST_LEN, DIFF_H, 2 * DIFF_DH), 1.0),
        "cache_conv": nrm(ks[4], (DEPTH, DEC_BATCH, CONV_K - 1, CONV_W), 1.0),
        "cache_mem_k": nrm(ks[5], (DEPTH, DEC_BATCH, N_MEM, MEM_H, MEM_DH), 1.0),
        "cache_mem_v": nrm(ks[6], (DEPTH, DEC_BATCH, N_MEM, MEM_H, MEM_DH), 1.0),
        "mem_prompt": nrm(ks[7], (BATCH, N_MEM, D_MODEL), 1.0),
        "rel_bias_table": nrm(ks[8], (N_BUCKETS, DIFF_H), 0.5),
        "w_in": nrm(ks[9], (DEPTH, D_MODEL, PROJ_TOTAL), D_MODEL ** -0.5),
        "w_mem_kv": nrm(ks[10], (DEPTH, D_MODEL, 2 * MEM_WIDTH), D_MODEL ** -0.5),
        "conv_w": nrm(ks[11], (DEPTH, CONV_K, CONV_W), 0.5),
        "lambda_q1": nrm(ks[12], (DEPTH, DIFF_DH), 0.1),
        "lambda_k1": nrm(ks[13], (DEPTH, DIFF_DH), 0.1),
        "lambda_q2": nrm(ks[14], (DEPTH, DIFF_DH), 0.1),
        "lambda_k2": nrm(ks[15], (DEPTH, DIFF_DH), 0.1),
        "subln_g": 1.0 + nrm(ks[16], (DEPTH, 2 * DIFF_DH), 0.02),
        "w_out": nrm(ks[17], (DEPTH, MIX_WIDTH, D_MODEL), BETA * MIX_WIDTH ** -0.5),
        "ln_g": 1.0 + nrm(ks[18], (DEPTH, D_MODEL), 0.02),
        "ln_b": nrm(ks[19], (DEPTH, D_MODEL), 0.02),
    }


def reference(x_prompt, x_sample, cache_diff_k, cache_diff_v, cache_conv, cache_mem_k, cache_mem_v,
              mem_prompt, rel_bias_table, w_in, w_mem_kv, conv_w, lambda_q1, lambda_k1, lambda_q2,
              lambda_k2, subln_g, w_out, ln_g, ln_b):
    xp, xs = x_prompt, x_sample
    bp, sp = xp.shape[0], xp.shape[1]
    bs, ss = xs.shape[0], xs.shape[1]
    past = cache_diff_k.shape[2]
    kp_l, vp_l, cp_l, mkp_l, mvp_l, ks_l, vs_l, cs_l = [], [], [], [], [], [], [], []

    for l in range(DEPTH):
        lam_init = 0.8 - 0.6 * math.exp(-0.3 * l)
        lam = diff_lambda(lambda_q1[l], lambda_k1[l], lambda_q2[l], lambda_k2[l], lam_init)

        q, k, v, h, bg, cg, mq, g_d, g_c, g_m = in_projection(xp, w_in[l])
        o_diff = prompt_diff_attention(q, k, v, lam, rel_bias_table)
        u = cg * h
        u_pad = jnp.concatenate([jnp.zeros((bp, CONV_K - 1, CONV_W), u.dtype), u], axis=1)
        conv_y = bg * causal_conv(u_pad, conv_w[l], sp)
        mkv = jnp.einsum('bmd,de->bme', mem_prompt, w_mem_kv[l])
        mk, mv = jnp.split(mkv, 2, axis=-1)
        mk = mk.reshape(bp, N_MEM, MEM_H, MEM_DH)
        mv = mv.reshape(bp, N_MEM, MEM_H, MEM_DH)
        o_mem = mem_attention(mq, mk, mv)
        kp_l.append(k.reshape(bp, sp, DIFF_H, 2 * DIFF_DH))
        vp_l.append(v)
        cp_l.append(u[:, sp - (CONV_K - 1):])
        mkp_l.append(mk)
        mvp_l.append(mv)
        xp = merge_and_norm(xp, o_diff, conv_y, o_mem, g_d, g_c, g_m, subln_g[l], lam_init,
                            w_out[l], ln_g[l], ln_b[l])

        q, k, v, h, bg, cg, mq, g_d, g_c, g_m = in_projection(xs, w_in[l])
        k_all = jnp.concatenate([cache_diff_k[l].reshape(bs, past, DIFF_H, 2, DIFF_DH), k], axis=1)
        v_all = jnp.concatenate([cache_diff_v[l], v], axis=1)
        qpos = past + jnp.arange(ss)
        kpos = jnp.arange(past + ss)
        o_diff = diff_attention(q, k_all, v_all, rel_bias(qpos, kpos, rel_bias_table),
                                chunk_mask(qpos, kpos), lam)
        u = cg * h
        u_pad = jnp.concatenate([cache_conv[l], u], axis=1)
        conv_y = bg * causal_conv(u_pad, conv_w[l], ss)
        o_mem = mem_attention(mq, cache_mem_k[l], cache_mem_v[l])
        ks_l.append(k.reshape(bs, ss, DIFF_H, 2 * DIFF_DH))
        vs_l.append(v)
        cs_l.append(u_pad[:, ss:])
        xs = merge_and_norm(xs, o_diff, conv_y, o_mem, g_d, g_c, g_m, subln_g[l], lam_init,
                            w_out[l], ln_g[l], ln_b[l])

    return (xp, xs, jnp.stack(kp_l), jnp.stack(vp_l), jnp.stack(cp_l), jnp.stack(mkp_l),
            jnp.stack(mvp_l), jnp.stack(ks_l), jnp.stack(vs_l), jnp.stack(cs_l))
```

```cpp
#include <hip/hip_runtime.h>
#include <hip/hip_cooperative_groups.h>
#include <cstdio>
namespace cg = cooperative_groups;

typedef unsigned short u16;
using bf16x8 = __attribute__((ext_vector_type(8))) short;
using f32x16 = __attribute__((ext_vector_type(16))) float;
typedef __bf16 bf2_t __attribute__((ext_vector_type(2)));
typedef float f2_t __attribute__((ext_vector_type(2)));
typedef unsigned u32x4 __attribute__((ext_vector_type(4)));
typedef unsigned u32x2 __attribute__((ext_vector_type(2)));
#define DI __device__ __forceinline__
#define MFMA(a, b, c) __builtin_amdgcn_mfma_f32_32x32x16_bf16((a), (b), (c), 0, 0, 0)

#ifndef STOP_AFTER
#define STOP_AFTER 9
#define P0_PART 0
#ifndef PROBE_B
#define PROBE_B 0
#define PROBE_B_LO 0
#define PROBE_B_HI 2048
#endif
#ifndef PROBE_A
#define PROBE_A 1
#endif
#ifndef PROBE_C
#define PROBE_C 1
#endif
#endif
constexpr int NTHR = 512;
constexpr int SEQ = 16384;
constexpr int NPROMPT = 32768;
constexpr int NTOK = 33280;
constexpr int SKV = 1088;
constexpr int SMEM_BYTES = 147456;
constexpr float LOG2E = 1.4426950408889634f;
constexpr float ALPHA_RES = 1.189207115002721f;
constexpr float EPSV = 1e-5f;

constexpr size_t O_Y = 0;
constexpr size_t O_KP = 68157440;
constexpr size_t O_VP = 101711872;
constexpr size_t O_CP = 135266304;
constexpr size_t O_MKP = 135268352;
constexpr size_t O_MVP = 135530496;
constexpr size_t O_KS = 135792640;
constexpr size_t O_VS = 136316928;
constexpr size_t O_CS = 136841216;

struct Params {
  const float *x_prompt, *x_sample, *cache_k, *cache_v, *cache_conv, *cache_mk, *cache_mv, *mem_prompt, *rel_table,
      *w_in, *w_memkv, *conv_w, *lq1, *lk1, *lq2, *lk2, *subln_g, *w_out, *ln_g, *ln_b;
  float* out;
  int* counter;
  int* gbarw;
  int* lnready;
  long long mode;
  u16 *Xb, *Mb, *WinT, *WmemT, *WoutT, *Qb, *Kall, *VTp, *VTs, *Hb, *Bb, *Cb, *MQb, *Gb, *MKall, *MVTall;
};

DI int crow(int i, int hh) { return (i & 3) + 8 * (i >> 2) + 4 * hh; }
DI unsigned pack2(float a, float b) {
  f2_t v = {a, b};
  bf2_t r = __builtin_convertvector(v, bf2_t);
  return __builtin_bit_cast(unsigned, r);
}
DI float bf2f(u16 v) { return __uint_as_float(((unsigned)v) << 16); }
DI float silu_f(float x) { return x / (1.f + __expf(-x)); }

DI void cvt8(const float* src, u16* dst) {
  const float4 a = *reinterpret_cast<const float4*>(src);
  const float4 b = *reinterpret_cast<const float4*>(src + 4);
  uint4 o;
  o.x = pack2(a.x, a.y); o.y = pack2(a.z, a.w); o.z = pack2(b.x, b.y); o.w = pack2(b.z, b.w);
  *reinterpret_cast<uint4*>(dst) = o;
}

DI void cvt_stream(const float* __restrict__ src, u16* __restrict__ dst, size_t ngroups, size_t gtid, size_t gn) {
  size_t g = gtid;
  for (; g + 3 * gn < ngroups; g += 4 * gn) {
    float4 a[4], b[4];
#pragma unroll
    for (int i = 0; i < 4; ++i) {
      a[i] = *reinterpret_cast<const float4*>(src + (g + i * gn) * 8);
      b[i] = *reinterpret_cast<const float4*>(src + (g + i * gn) * 8 + 4);
    }
#pragma unroll
    for (int i = 0; i < 4; ++i) {
      uint4 o;
      o.x = pack2(a[i].x, a[i].y); o.y = pack2(a[i].z, a[i].w); o.z = pack2(b[i].x, b[i].y); o.w = pack2(b[i].z, b[i].w);
      *reinterpret_cast<uint4*>(dst + (g + i * gn) * 8) = o;
    }
  }
  for (; g < ngroups; g += gn) cvt8(src + g * 8, dst + g * 8);
}

DI void transpose_tile(const float* src, size_t src_ld, u16* dst, size_t dst_ld, bool perm, float* sm) {
  const int tid = threadIdx.x;
#pragma unroll
  for (int i = 0; i < 2; ++i) {
    const int idx = tid + NTHR * i;
    const int row = idx >> 4, c4 = (idx & 15) * 4;
    const float4 v = *reinterpret_cast<const float4*>(src + (size_t)row * src_ld + c4);
    float* d = sm + row * 65 + c4;
    d[0] = v.x; d[1] = v.y; d[2] = v.z; d[3] = v.w;
  }
  __syncthreads();
  const int c = tid >> 3, seg = tid & 7;
  float v[8];
#pragma unroll
  for (int j = 0; j < 8; ++j) {
    int rr;
    if (perm) {
      const int gi = seg >> 1, half = seg & 1;
      rr = 16 * gi + ((j < 4) ? (4 * half + j) : (8 + 4 * half + (j - 4)));
    } else {
      rr = seg * 8 + j;
    }
    v[j] = sm[rr * 65 + c];
  }
  uint4 o;
  o.x = pack2(v[0], v[1]); o.y = pack2(v[2], v[3]); o.z = pack2(v[4], v[5]); o.w = pack2(v[6], v[7]);
  *reinterpret_cast<uint4*>(dst + (size_t)c * dst_ld + seg * 8) = o;
  __syncthreads();
}

__device__ void phase0(const Params& p, unsigned char* smem) {
  const int tid = threadIdx.x;
  const size_t gtid = (size_t)blockIdx.x * NTHR + tid;
  const size_t gn = (size_t)gridDim.x * NTHR;
  if (blockIdx.x == 0 && tid < 64) { p.counter[tid] = 0; p.lnready[tid] = 0; }
  cvt_stream(p.x_prompt, p.Xb, (size_t)NPROMPT * 256, gtid, gn);
  for (size_t g = gtid; g < (size_t)512 * 256; g += gn) cvt8(p.x_sample + g * 8, p.Xb + (size_t)NPROMPT * 2048 + g * 8);
  for (size_t g = gtid; g < (size_t)512 * 256; g += gn) cvt8(p.mem_prompt + g * 8, p.Mb + g * 8);
  cvt_stream(p.cache_mk, p.MKall + (size_t)2 * 256 * 512, (size_t)32 * 256 * 64, gtid, gn);
  for (int b = 0; b < 32; ++b)
    cvt_stream(p.cache_k + (size_t)b * 1024 * 1024, p.Kall + ((size_t)NPROMPT + (size_t)b * SKV) * 1024, (size_t)1024 * 128, gtid, gn);
  for (size_t g = gtid; g < (size_t)32768 * 6; g += gn) {
    const size_t row = g / 6, ch = g % 6;
    *reinterpret_cast<uint4*>(p.VTs + row * SKV + 1040 + ch * 8) = make_uint4(0, 0, 0, 0);
  }
#if P0_PART == 1
  return;
#endif
  float* sm = reinterpret_cast<float*>(smem);
  constexpr int T_WIN = 32 * 112, T_WMEM = 32 * 16, T_WOUT = 32 * 32, T_CV = 32 * 8 * 16 * 2, T_MV = 32 * 4 * 4 * 2;
  constexpr int T_ALL = T_WIN + T_WMEM + T_WOUT + T_CV + T_MV;
  for (int t = blockIdx.x; t < T_ALL; t += gridDim.x) {
    int u = t;
    if (u < T_WIN) {
      const int kt = u & 31, nt = u >> 5;
      transpose_tile(p.w_in + (size_t)kt * 64 * 7168 + nt * 64, 7168, p.WinT + (size_t)nt * 64 * 2048 + kt * 64, 2048, false, sm);
      continue;
    }
    u -= T_WIN;
    if (u < T_WMEM) {
      const int kt = u & 31, nt = u >> 5;
      transpose_tile(p.w_memkv + (size_t)kt * 64 * 1024 + nt * 64, 1024, p.WmemT + (size_t)nt * 64 * 2048 + kt * 64, 2048, false, sm);
      continue;
    }
    u -= T_WMEM;
    if (u < T_WOUT) {
      const int kt = u & 31, nt = u >> 5;
      transpose_tile(p.w_out + (size_t)kt * 64 * 2048 + nt * 64, 2048, p.WoutT + (size_t)nt * 64 * 2048 + kt * 64, 2048, false, sm);
      continue;
    }
    u -= T_WOUT;
    if (u < T_CV) {
      const int et = u & 1, st = (u >> 1) & 15, bh = u >> 5;
      const int b = bh >> 3, h = bh & 7;
      transpose_tile(p.cache_v + ((size_t)b * 1024 + st * 64) * 1024 + h * 128 + et * 64, 1024,
                     p.VTs + ((size_t)bh * 128 + et * 64) * SKV + st * 64, SKV, true, sm);
      continue;
    }
    u -= T_CV;
    {
      const int et = u & 1, st = (u >> 1) & 3, bh = u >> 3;
      const int b = bh >> 2, h = bh & 3;
      transpose_tile(p.cache_mv + ((size_t)b * 256 + st * 64) * 512 + h * 128 + et * 64, 512,
                     p.MVTall + ((size_t)(2 * 4 + bh) * 128 + et * 64) * 256 + st * 64, 256, true, sm);
    }
  }
}

#define LAS __attribute__((address_space(3)))
using f32x4 = __attribute__((ext_vector_type(4))) float;
constexpr int G_BK = 64, G_HALF = 128, G_HTB = G_HALF * G_BK * 2;

DI int lds_byte(int r, int c) { const int st = (r >> 4) * 2 + (c >> 5), rr = r & 15, cc = c & 31, ob = rr * 64 + cc * 2; return st * 1024 + (ob ^ (((ob >> 9) & 1) << 5)); }
DI void stage_rc(int b, int& R, int& C) { const int st = b / 1024, sb = b % 1024, swz = sb ^ (((sb >> 9) & 1) << 5); R = (st >> 1) * 16 + swz / 64; C = (st & 1) * 32 + (swz % 64) / 2; }
DI int perm32(int rho) { const int n = rho >> 4, i = rho & 15; return 8 * (i >> 2) + 4 * n + (i & 3); }

struct Unit { const char* a; const char* b; int pm, pn, kind; };
constexpr size_t TSTEP = (size_t)256 * 2048 * 2;

struct SchedIn {
  const Params* p; int G, c;
  DI bool next(int i, Unit& u) const {
    const int L = i * G + c;
    if (L >= 3648) return false;
    int mt, nt;
    if (L < 3584) {
      const int lb = L & 255, P = (L >> 8) * 8 + (lb & 7), li = lb >> 3;
      nt = (P % 7) * 4 + (li & 3); mt = (P / 7) * 8 + (li >> 2);
    } else if (L < 3640) { const int j = L - 3584; mt = 128 + (j & 1); nt = j >> 1; }
    else {
      const int j = L - 3640; u.pm = j >> 2; u.pn = j & 3; u.kind = 1;
      u.a = (const char*)p->Mb + (size_t)u.pm * TSTEP; u.b = (const char*)p->WmemT + (size_t)u.pn * TSTEP;
      return true;
    }
    u.pm = mt; u.pn = nt; u.kind = 0;
    u.a = (const char*)p->Xb + (size_t)mt * TSTEP; u.b = (const char*)p->WinT + (size_t)nt * TSTEP;
    return true;
  }
};
struct SchedOut {
  const Params* p; int G, c;
  DI bool next(int i, Unit& u) const {
    const int L = i * G + c;
    if (L >= 1040) return false;
    int mt, nt;
    if (L < 1024) { mt = 8 * (L >> 6) + (L & 7); nt = (L >> 3) & 7; }
    else { const int j = L - 1024; mt = 128 + (j & 1); nt = j >> 1; }
    u.pm = mt; u.pn = nt; u.kind = 2;
    u.a = (const char*)p->Xb + (size_t)mt * TSTEP; u.b = (const char*)p->WoutT + (size_t)nt * TSTEP;
    return true;
  }
};

DI int perm_pos(int s) { return (s & ~12) | ((s & 4) << 1) | ((s & 8) >> 1); }

struct EpiAll {
  const Params* p;
  bool handoff;
  DI void done(const Unit& u, int ui, bool has_next, int lane) const {
    if (handoff && u.kind == 2 && ui == 3 && has_next) {
      __builtin_amdgcn_fence(__ATOMIC_RELEASE, "agent");
      if (lane == 0) __hip_atomic_fetch_add(p->lnready, 1, __ATOMIC_RELAXED, __HIP_MEMORY_SCOPE_AGENT);
    }
    if (handoff && u.kind != 2 && ui == 13 && has_next) {
      __builtin_amdgcn_fence(__ATOMIC_RELEASE, "agent");
      if (lane == 0) __hip_atomic_fetch_add(p->lnready + 8, 1, __ATOMIC_RELAXED, __HIP_MEMORY_SCOPE_AGENT);
    }
  }
  DI void operator()(const f32x4 (&acc)[2][2][4][2], const Unit& u, int wr, int wc, int fr, int fq) const {
    const Params& P = *p;
    const int m0 = u.pm * 256, n0 = u.pn * 256;
    const int rbase = m0 + wr * 64 + fr;
    const int cbase = wc * 32 + 8 * fq;
    if (u.kind == 2) {
#pragma unroll
      for (int ai = 0; ai < 2; ++ai)
#pragma unroll
        for (int mp = 0; mp < 2; ++mp) {
          f32x4 xv[2][2][2];
#pragma unroll
          for (int mm = 0; mm < 2; ++mm) {
            const int row = rbase + ai * 128 + (mp * 2 + mm) * 16;
            const float* __restrict__ xs = (row < NPROMPT) ? (P.x_prompt + (size_t)row * 2048) : (P.x_sample + (size_t)(row - NPROMPT) * 2048);
#pragma unroll
            for (int bj = 0; bj < 2; ++bj) {
              const int col = n0 + cbase + bj * 128;
              xv[mm][bj][0] = *reinterpret_cast<const f32x4*>(xs + col);
              xv[mm][bj][1] = *reinterpret_cast<const f32x4*>(xs + col + 4);
            }
          }
#pragma unroll
          for (int mm = 0; mm < 2; ++mm) {
            const int row = rbase + ai * 128 + (mp * 2 + mm) * 16;
            float* __restrict__ od = P.out + O_Y + (size_t)row * 2048;
#pragma unroll
            for (int bj = 0; bj < 2; ++bj) {
              const int col = n0 + cbase + bj * 128;
              *reinterpret_cast<f32x4*>(od + col) = xv[mm][bj][0] * ALPHA_RES + acc[ai][bj][mp * 2 + mm][0];
              *reinterpret_cast<f32x4*>(od + col + 4) = xv[mm][bj][1] * ALPHA_RES + acc[ai][bj][mp * 2 + mm][1];
            }
          }
        }
      return;
    }
    u16* bdst = nullptr; float* fdst = nullptr; u16* vdst = nullptr;
    int bld = 0, fld = 0, coff = 0, kremap = 0, frow_off = 0;
    int vshift = 0, vbatch = 0, vld = 0, vposoff = 0, vrow_off = 0;
    float scale = 1.f; int dosilu = 0;
    if (u.kind == 0) {
      const bool sample = (m0 >= NPROMPT);
      if (n0 < 1024) { bdst = P.Qb; bld = 1024; coff = 0; scale = 0.125f * LOG2E; }
      else if (n0 < 2048) {
        bdst = P.Kall; bld = 1024; coff = 1024; kremap = 1;
        fdst = P.out + (sample ? O_KS : O_KP); fld = 1024; frow_off = sample ? NPROMPT : 0;
      } else if (n0 < 3072) {
        coff = 2048;
        fdst = P.out + (sample ? O_VS : O_VP); fld = 1024; frow_off = sample ? NPROMPT : 0;
        if (!sample) { vdst = P.VTp; vshift = 14; vbatch = 1024; vld = SEQ; vposoff = 0; vrow_off = 0; }
        else { vdst = P.VTs; vshift = 4; vbatch = 1024; vld = SKV; vposoff = 1024; vrow_off = NPROMPT; }
      } else if (n0 < 3584) { bdst = P.Hb; bld = 512; coff = 3072; }
      else if (n0 < 4096) { bdst = P.Bb; bld = 512; coff = 3584; }
      else if (n0 < 4608) { bdst = P.Cb; bld = 512; coff = 4096; }
      else if (n0 < 5120) { bdst = P.MQb; bld = 512; coff = 4608; scale = 0.08838834764831845f * LOG2E; }
      else { bdst = P.Gb; bld = 2048; coff = 5120; dosilu = 1; }
    } else {
      if (n0 < 512) { bdst = P.MKall; bld = 512; coff = 0; fdst = P.out + O_MKP; fld = 512; }
      else { coff = 512; fdst = P.out + O_MVP; fld = 512; vdst = P.MVTall; vshift = 8; vbatch = 512; vld = 256; }
    }
    const int c0 = n0 - coff + cbase;
#pragma unroll
    for (int ai = 0; ai < 2; ++ai)
#pragma unroll
      for (int m = 0; m < 4; ++m) {
        const int row = rbase + ai * 128 + m * 16;
#pragma unroll
        for (int bj = 0; bj < 2; ++bj) {
          const int col = c0 + bj * 128;
          const f32x4 a0 = acc[ai][bj][m][0], a1 = acc[ai][bj][m][1];
          if (bdst != nullptr) {
            float v[8] = {a0[0] * scale, a0[1] * scale, a0[2] * scale, a0[3] * scale, a1[0] * scale, a1[1] * scale, a1[2] * scale, a1[3] * scale};
            if (dosilu) {
#pragma unroll
              for (int j = 0; j < 8; ++j) v[j] = silu_f(v[j]);
              if (col < 1024) {
                const f32x4 s0 = *reinterpret_cast<const f32x4*>(P.subln_g + (col & 127));
                const f32x4 s1 = *reinterpret_cast<const f32x4*>(P.subln_g + (col & 127) + 4);
#pragma unroll
                for (int j = 0; j < 4; ++j) { v[j] *= s0[j] * 0.8f; v[4 + j] *= s1[j] * 0.8f; }
              }
            }
            u32x4 pk;
            pk.x = pack2(v[0], v[1]); pk.y = pack2(v[2], v[3]); pk.z = pack2(v[4], v[5]); pk.w = pack2(v[6], v[7]);
            size_t drow = (size_t)row;
            if (kremap && row >= NPROMPT) { const int rs = row - NPROMPT; drow = (size_t)NPROMPT + (size_t)(rs >> 4) * SKV + 1024 + (rs & 15); }
            *reinterpret_cast<u32x4*>(bdst + drow * bld + col) = pk;
          }
          if (fdst != nullptr) {
            float* fp = fdst + (size_t)(row - frow_off) * fld + col;
            *reinterpret_cast<f32x4*>(fp) = a0;
            *reinterpret_cast<f32x4*>(fp + 4) = a1;
          }
          if (vdst != nullptr) {
            const int rv = row - vrow_off;
            const int bidx = rv >> vshift, s = rv & ((1 << vshift) - 1);
            const bool odd = (fr & 1) != 0;
            float rcv[4];
#pragma unroll
            for (int k = 0; k < 4; ++k) rcv[k] = __shfl_xor(odd ? a0[k] : a1[k], 1);
            u16* vp = vdst + (size_t)(bidx * vbatch + col + (odd ? 4 : 0)) * vld + vposoff + perm_pos(s & ~1);
#pragma unroll
            for (int k = 0; k < 4; ++k) {
              const unsigned pk = odd ? pack2(rcv[k], a1[k]) : pack2(a0[k], rcv[k]);
              *reinterpret_cast<unsigned*>(vp + (size_t)k * vld) = pk;
            }
          }
        }
      }
  }
};

template <class Epi, class Sched>
DI void gemm_phase(LAS unsigned char* lds, const Sched& S, const Epi& E) {
  int tidl = threadIdx.x; asm volatile("" : "+v"(tidl));
  const int tid = tidl, wid = __builtin_amdgcn_readfirstlane(tid >> 6), lane = tid & 63, wr = wid >> 2, wc = wid & 3, fr = lane & 15, fq = lane >> 4;
  constexpr int K = 2048, nt = K / G_BK;
  unsigned voffA[2], voffB[2];
#pragma unroll
  for (int i = 0; i < 2; ++i) {
    int R, C; stage_rc(tid * 16 + i * 8192, R, C);
    const int Rb = (R & ~31) + perm32(R & 31);
    voffA[i] = (unsigned)(R * K + C) * 2u; voffB[i] = (unsigned)(Rb * K + C) * 2u;
  }
  constexpr size_t kstep = (size_t)(G_BK * 2);
  constexpr size_t hstep = (size_t)G_HALF * K * 2;
  const unsigned ldsw = (unsigned)wid * 1024u;
  const int aoff = lds_byte(wr * 64 + fr, fq * 8), boff = lds_byte(wc * 32 + fr, fq * 8);
#define PG8_SA(b, h) (((b) * 2 + (h)) * G_HTB)
#define PG8_SB(b, h) ((4 + (b) * 2 + (h)) * G_HTB)
#define PG8_STAGE(bufoff, gbase, voff) do { _Pragma("unroll") for (int _i = 0; _i < 2; ++_i) \
    __builtin_amdgcn_global_load_lds((const unsigned*)((const char*)(gbase) + (voff)[_i]), (LAS unsigned*)(lds + (bufoff) + ldsw + _i * 8192), 16, 0, 0); } while (0)
#define PG8_LDA(dst, b, h) do { _Pragma("unroll") for (int m = 0; m < 4; ++m) _Pragma("unroll") for (int k = 0; k < 2; ++k) dst[m][k] = *(const LAS bf16x8*)(lds + PG8_SA(b, h) + aoff + m * 2048 + k * 1024); } while (0)
#define PG8_LDB(dst, b, h) do { _Pragma("unroll") for (int n = 0; n < 2; ++n) _Pragma("unroll") for (int k = 0; k < 2; ++k) dst[n][k] = *(const LAS bf16x8*)(lds + PG8_SB(b, h) + boff + n * 2048 + k * 1024); } while (0)
#define PG8_MMA(ai, bj, At, Bt) do { __builtin_amdgcn_s_setprio(1); _Pragma("unroll") for (int m = 0; m < 4; ++m) _Pragma("unroll") for (int n = 0; n < 2; ++n) _Pragma("unroll") for (int k = 0; k < 2; ++k) \
    acc[ai][bj][m][n] = __builtin_amdgcn_mfma_f32_16x16x32_bf16(Bt[n][k], At[m][k], acc[ai][bj][m][n], 0, 0, 0); __builtin_amdgcn_s_setprio(0); } while (0)
#define PG8_WAIT_V(n) asm volatile("s_waitcnt vmcnt(" #n ")" ::: "memory")
#define PG8_WAIT_L(n) asm volatile("s_waitcnt lgkmcnt(" #n ")" ::: "memory")
#define PG8_BAR __builtin_amdgcn_s_barrier()
#define PG8_SCHED __builtin_amdgcn_sched_barrier(0)
  Unit cur, nxt; int ui = 0;
  if (!S.next(0, cur)) return;
  f32x4 acc[2][2][4][2];
#pragma unroll
  for (int a = 0; a < 2; ++a)
#pragma unroll
    for (int b = 0; b < 2; ++b)
#pragma unroll
      for (int m = 0; m < 4; ++m)
#pragma unroll
        for (int n = 0; n < 2; ++n) acc[a][b][m][n] = (f32x4){0.f, 0.f, 0.f, 0.f};
  bf16x8 At[4][2], B0[2][2], B1[2][2];
  const char* cA = cur.a; const char* cB = cur.b;
  PG8_STAGE(PG8_SB(0, 0), cB, voffB); PG8_STAGE(PG8_SA(0, 0), cA, voffA); PG8_STAGE(PG8_SB(0, 1), cB + hstep, voffB); PG8_STAGE(PG8_SA(0, 1), cA + hstep, voffA);
  if (wr == 1) PG8_BAR;
  PG8_WAIT_V(4); PG8_BAR;
  PG8_STAGE(PG8_SB(1, 0), cB + kstep, voffB); PG8_STAGE(PG8_SA(1, 0), cA + kstep, voffA); PG8_STAGE(PG8_SB(1, 1), cB + hstep + kstep, voffB);
  PG8_WAIT_V(6); PG8_BAR;
  for (;;) {
    const bool has_next = S.next(ui + 1, nxt);
    const char* nA = has_next ? nxt.a : cA; const char* nB = has_next ? nxt.b : cB;
    for (int t = 0; t < nt; t += 2) {
      const bool last = (t == nt - 2);
      const char* a1 = cA + (size_t)(t + 1) * kstep;
      const char* a2 = last ? nA : cA + (size_t)(t + 2) * kstep; const char* b2 = last ? nB : cB + (size_t)(t + 2) * kstep;
      const char* a3 = a2 + kstep; const char* b3 = b2 + kstep;
      PG8_LDB(B0, 0, 0); PG8_SCHED; PG8_LDA(At, 0, 0); PG8_STAGE(PG8_SA(1, 1), a1 + hstep, voffA);
      PG8_WAIT_L(8); PG8_BAR; PG8_WAIT_L(0); PG8_MMA(0, 0, At, B0); PG8_BAR; PG8_SCHED;
      PG8_LDB(B1, 0, 1); PG8_STAGE(PG8_SB(0, 0), b2, voffB);
      PG8_BAR; PG8_WAIT_L(0); PG8_MMA(0, 1, At, B1); PG8_BAR;
      PG8_LDA(At, 0, 1); PG8_STAGE(PG8_SA(0, 0), a2, voffA);
      PG8_BAR; PG8_WAIT_L(0); PG8_MMA(1, 0, At, B0); PG8_BAR; PG8_SCHED;
      PG8_STAGE(PG8_SB(0, 1), b2 + hstep, voffB);
      PG8_WAIT_V(6); PG8_BAR; PG8_MMA(1, 1, At, B1); PG8_BAR;
      PG8_LDB(B0, 1, 0); PG8_SCHED; PG8_LDA(At, 1, 0); PG8_STAGE(PG8_SA(0, 1), a2 + hstep, voffA);
      PG8_WAIT_L(8); PG8_BAR; PG8_WAIT_L(0); PG8_MMA(0, 0, At, B0); PG8_BAR; PG8_SCHED;
      PG8_LDB(B1, 1, 1); PG8_STAGE(PG8_SB(1, 0), b3, voffB);
      PG8_BAR; PG8_WAIT_L(0); PG8_MMA(0, 1, At, B1); PG8_BAR;
      PG8_LDA(At, 1, 1); PG8_STAGE(PG8_SA(1, 0), a3, voffA);
      PG8_BAR; PG8_WAIT_L(0); PG8_MMA(1, 0, At, B0); PG8_BAR; PG8_SCHED;
      PG8_STAGE(PG8_SB(1, 1), b3 + hstep, voffB);
      PG8_WAIT_V(6); PG8_BAR; PG8_MMA(1, 1, At, B1); PG8_BAR;
    }
    E(acc, cur, wr, wc, fr, fq);
    E.done(cur, ui, has_next, lane);
    if (!has_next) break;
#pragma unroll
    for (int a = 0; a < 2; ++a)
#pragma unroll
      for (int b = 0; b < 2; ++b)
#pragma unroll
        for (int m = 0; m < 4; ++m)
#pragma unroll
          for (int n = 0; n < 2; ++n) acc[a][b][m][n] = (f32x4){0.f, 0.f, 0.f, 0.f};
    cur = nxt; cA = nA; cB = nB; ++ui;
  }
  PG8_WAIT_V(0);
  if (wr == 0) PG8_BAR;
  PG8_BAR;
#undef PG8_SA
#undef PG8_SB
#undef PG8_STAGE
#undef PG8_LDA
#undef PG8_LDB
#undef PG8_MMA
#undef PG8_WAIT_V
#undef PG8_WAIT_L
#undef PG8_BAR
#undef PG8_SCHED
}

constexpr int TILEB = 35840;
constexpr int LUT_OFF = 2 * TILEB;
constexpr int MISC_OFF = LUT_OFF + 8192;

template <int NKS>
DI void flash_core(unsigned char* smem, const u16* qptr, const u16* kbase, int kld, const u16* vtbase, int vld,
                   int ntb, int ntw, int nvalid, int ks0, const float* lut, int qpos, bool active,
                   f32x16 (&O)[4], float& m_out, float& l_out) {
  int tid = threadIdx.x; asm volatile("" : "+v"(tid));
  const int lane = tid & 63;
  const int r = lane & 31, hh = lane >> 5;
  bf16x8 qf[NKS];
#pragma unroll
  for (int s = 0; s < NKS; ++s) qf[s] = *reinterpret_cast<const bf16x8*>(qptr + s * 16);
#pragma unroll
  for (int t = 0; t < 4; ++t)
#pragma unroll
    for (int e = 0; e < 16; ++e) O[t][e] = 0.f;
  float m = -1e30f, l = 0.f;

  const int krow = tid >> 4, kch = tid & 15;
  const u16* kg = kbase + (size_t)krow * kld + kch * 8;
  const int vrow = tid >> 3, vch = tid & 7;
  const u16* vg = vtbase + (size_t)vrow * vld + vch * 8;
  const int ksoff = krow * 272 + kch * 16;
  const int vsoff = 17408 + vrow * 144 + vch * 16;
  u32x4 kr0, kr1, vr0, vr1;
  kr0 = *reinterpret_cast<const u32x4*>(kg);
  kr1 = *reinterpret_cast<const u32x4*>(kg + (size_t)32 * kld);
  vr0 = *reinterpret_cast<const u32x4*>(vg);
  vr1 = *reinterpret_cast<const u32x4*>(vg + (size_t)64 * vld);
  *reinterpret_cast<u32x4*>(smem + ksoff) = kr0;
  *reinterpret_cast<u32x4*>(smem + ksoff + 32 * 272) = kr1;
  *reinterpret_cast<u32x4*>(smem + vsoff) = vr0;
  *reinterpret_cast<u32x4*>(smem + vsoff + 64 * 144) = vr1;
  __syncthreads();

  for (int t = 0; t < ntb; ++t) {
    const unsigned char* cur = smem + (t & 1) * TILEB;
    unsigned char* nxt = smem + ((t + 1) & 1) * TILEB;
    const bool more = (t + 1 < ntb);
    if (more) {
      kr0 = *reinterpret_cast<const u32x4*>(kg + (size_t)(64 * (t + 1)) * kld);
      kr1 = *reinterpret_cast<const u32x4*>(kg + (size_t)(64 * (t + 1) + 32) * kld);
      vr0 = *reinterpret_cast<const u32x4*>(vg + 64 * (t + 1));
      vr1 = *reinterpret_cast<const u32x4*>(vg + (size_t)64 * vld + 64 * (t + 1));
    }
    if (active && t < ntw) {
      f32x16 S[2];
#pragma unroll
      for (int kb = 0; kb < 2; ++kb)
#pragma unroll
        for (int e = 0; e < 16; ++e) S[kb][e] = 0.f;
      const unsigned char* kb0 = cur + r * 272 + (ks0 * 16 + hh * 8) * 2;
#pragma unroll
      for (int s = 0; s < NKS; ++s)
#pragma unroll
        for (int kb = 0; kb < 2; ++kb) {
          const bf16x8 kf = *reinterpret_cast<const bf16x8*>(kb0 + kb * 32 * 272 + s * 32);
          S[kb] = MFMA(kf, qf[s], S[kb]);
        }
      if (lut != nullptr && t >= ntw - 3) {
        const int base = t * 64 - qpos + 191;
#pragma unroll
        for (int kb = 0; kb < 2; ++kb)
#pragma unroll
          for (int i = 0; i < 16; ++i) S[kb][i] += lut[base + kb * 32 + crow(i, hh)];
      }
      if (t == ntw - 1 && nvalid < 64) {
#pragma unroll
        for (int kb = 0; kb < 2; ++kb)
#pragma unroll
          for (int i = 0; i < 16; ++i)
            if (kb * 32 + crow(i, hh) >= nvalid) S[kb][i] = -1e30f;
      }
      float mx = m;
#pragma unroll
      for (int kb = 0; kb < 2; ++kb)
#pragma unroll
        for (int i = 0; i < 16; ++i) mx = fmaxf(mx, S[kb][i]);
      mx = fmaxf(mx, __shfl_xor(mx, 32));
      const float alpha = __builtin_amdgcn_exp2f(m - mx);
      m = mx;
      float ps = 0.f;
#pragma unroll
      for (int kb = 0; kb < 2; ++kb)
#pragma unroll
        for (int i = 0; i < 16; ++i) {
          const float pv = __builtin_amdgcn_exp2f(S[kb][i] - mx);
          S[kb][i] = pv;
          ps += pv;
        }
      l = l * alpha + ps;
#pragma unroll
      for (int tt = 0; tt < 4; ++tt)
#pragma unroll
        for (int e = 0; e < 16; ++e) O[tt][e] *= alpha;
      const unsigned char* vb0 = cur + 17408 + r * 144 + hh * 16;
#pragma unroll
      for (int kb = 0; kb < 2; ++kb)
#pragma unroll
        for (int s2 = 0; s2 < 2; ++s2) {
          u32x4 pk;
          pk.x = pack2(S[kb][8 * s2 + 0], S[kb][8 * s2 + 1]);
          pk.y = pack2(S[kb][8 * s2 + 2], S[kb][8 * s2 + 3]);
          pk.z = pack2(S[kb][8 * s2 + 4], S[kb][8 * s2 + 5]);
          pk.w = pack2(S[kb][8 * s2 + 6], S[kb][8 * s2 + 7]);
          const bf16x8 pf = __builtin_bit_cast(bf16x8, pk);
#pragma unroll
          for (int tt = 0; tt < 4; ++tt) {
            const bf16x8 vf = *reinterpret_cast<const bf16x8*>(vb0 + tt * 32 * 144 + (kb * 32 + s2 * 16) * 2);
            O[tt] = MFMA(vf, pf, O[tt]);
          }
        }
    }
    if (more) {
      *reinterpret_cast<u32x4*>(nxt + ksoff) = kr0;
      *reinterpret_cast<u32x4*>(nxt + ksoff + 32 * 272) = kr1;
      *reinterpret_cast<u32x4*>(nxt + vsoff) = vr0;
      *reinterpret_cast<u32x4*>(nxt + vsoff + 64 * 144) = vr1;
    }
    __syncthreads();
  }
  m_out = m;
  l_out = l + __shfl_xor(l, 32);
}

constexpr int D_SLOT = 32768;
constexpr int D_LUT_OFF = 4 * D_SLOT;
constexpr int D_MISC_OFF = D_LUT_OFF + 8192;

DI void diff_core(unsigned char* smem, const u16* qptr, const u16* kbase, const u16* vtbase, int vld,
                  int ntb, int ntw, int nvalid, int ks0, const float* lut, int qpos, bool active, bool grpB,
                  f32x16 (&O)[4], float& l_out) {
  int tid = threadIdx.x; asm volatile("" : "+v"(tid));
  const int lane = tid & 63, w = __builtin_amdgcn_readfirstlane(tid >> 6);
  const int r = lane & 31, hh = lane >> 5;
  constexpr int kld = 1024;
  LAS unsigned char* lds = (LAS unsigned char*)smem;
  bf16x8 qf[4];
#pragma unroll
  for (int s = 0; s < 4; ++s) qf[s] = *reinterpret_cast<const bf16x8*>(qptr + s * 16);
#pragma unroll
  for (int t = 0; t < 4; ++t)
#pragma unroll
    for (int e = 0; e < 16; ++e) O[t][e] = 0.f;
  float m = 0.f, l = 0.f;
  f32x16 S[2];
  u32x4 P[4];
#pragma unroll
  for (int i = 0; i < 4; ++i) P[i] = (u32x4){0u, 0u, 0u, 0u};
#pragma unroll
  for (int kb = 0; kb < 2; ++kb)
#pragma unroll
    for (int e = 0; e < 16; ++e) S[kb][e] = 0.f;

  unsigned ksrc[2], vsrc[2];
#pragma unroll
  for (int i = 0; i < 2; ++i) {
    const int ci = (i * 8 + w) * 64 + lane;
    const int krow = ci >> 4, kc = (ci & 15) ^ (krow & 15);
    ksrc[i] = (unsigned)(krow * kld + kc * 8) * 2u;
    const int vrow = ci >> 3, vc = (ci & 7) ^ ((vrow >> 1) & 7);
    vsrc[i] = (unsigned)(vrow * vld + vc * 8) * 2u;
  }
  auto dma_piece = [&](int t, int slot, int piece) {
    LAS unsigned char* b = lds + slot * D_SLOT + w * 1024;
    const char* kt = (const char*)kbase + (size_t)(64 * t) * kld * 2;
    const char* vt = (const char*)vtbase + (size_t)(64 * t) * 2;
    if (piece == 0) __builtin_amdgcn_global_load_lds((const unsigned*)(kt + ksrc[0]), (LAS unsigned*)(b), 16, 0, 0);
    else if (piece == 1) __builtin_amdgcn_global_load_lds((const unsigned*)(kt + ksrc[1]), (LAS unsigned*)(b + 8192), 16, 0, 0);
    else if (piece == 2) __builtin_amdgcn_global_load_lds((const unsigned*)(vt + vsrc[0]), (LAS unsigned*)(b + 16384), 16, 0, 0);
    else __builtin_amdgcn_global_load_lds((const unsigned*)(vt + vsrc[1]), (LAS unsigned*)(b + 24576), 16, 0, 0);
  };
  auto dma = [&](int t, int slot) { dma_piece(t, slot, 0); dma_piece(t, slot, 1); dma_piece(t, slot, 2); dma_piece(t, slot, 3); };
  int koff[4], voff[4];
#pragma unroll
  for (int s = 0; s < 4; ++s) {
    koff[s] = r * 256 + (((2 * (ks0 + s) + hh) ^ (r & 15)) << 4);
    voff[s] = 16384 + r * 128 + (((2 * s + hh) ^ ((r >> 1) & 7)) << 4);
  }
  auto qk = [&](int slot) {
    __builtin_amdgcn_s_setprio(1);
    const float ini = -m;
#pragma unroll
    for (int kb = 0; kb < 2; ++kb)
#pragma unroll
      for (int e = 0; e < 16; ++e) S[kb][e] = ini;
    const LAS unsigned char* b = lds + slot * D_SLOT;
    bf16x8 kf[4][2];
#pragma unroll
    for (int s = 0; s < 4; ++s)
#pragma unroll
      for (int kb = 0; kb < 2; ++kb) kf[s][kb] = *reinterpret_cast<const LAS bf16x8*>(b + koff[s] + kb * 32 * 256);
#pragma unroll
    for (int s = 0; s < 4; ++s)
#pragma unroll
      for (int kb = 0; kb < 2; ++kb) S[kb] = MFMA(kf[s][kb], qf[s], S[kb]);
    __builtin_amdgcn_sched_group_barrier(0x100, 8, 0);
    __builtin_amdgcn_sched_group_barrier(0x008, 8, 0);
    __builtin_amdgcn_s_setprio(0);
  };
  auto pv = [&](int slot) {
    __builtin_amdgcn_s_setprio(1);
    const LAS unsigned char* b = lds + slot * D_SLOT;
    bf16x8 va[4], vb[4];
#pragma unroll
    for (int tt = 0; tt < 4; ++tt) va[tt] = *reinterpret_cast<const LAS bf16x8*>(b + voff[0] + tt * 32 * 128);
#pragma unroll
    for (int tt = 0; tt < 4; ++tt) vb[tt] = *reinterpret_cast<const LAS bf16x8*>(b + voff[1] + tt * 32 * 128);
    {
      const bf16x8 pf = __builtin_bit_cast(bf16x8, P[0]);
#pragma unroll
      for (int tt = 0; tt < 4; ++tt) O[tt] = MFMA(va[tt], pf, O[tt]);
    }
#pragma unroll
    for (int tt = 0; tt < 4; ++tt) va[tt] = *reinterpret_cast<const LAS bf16x8*>(b + voff[2] + tt * 32 * 128);
    {
      const bf16x8 pf = __builtin_bit_cast(bf16x8, P[1]);
#pragma unroll
      for (int tt = 0; tt < 4; ++tt) O[tt] = MFMA(vb[tt], pf, O[tt]);
    }
#pragma unroll
    for (int tt = 0; tt < 4; ++tt) vb[tt] = *reinterpret_cast<const LAS bf16x8*>(b + voff[3] + tt * 32 * 128);
    {
      const bf16x8 pf = __builtin_bit_cast(bf16x8, P[2]);
#pragma unroll
      for (int tt = 0; tt < 4; ++tt) O[tt] = MFMA(va[tt], pf, O[tt]);
    }
    {
      const bf16x8 pf = __builtin_bit_cast(bf16x8, P[3]);
#pragma unroll
      for (int tt = 0; tt < 4; ++tt) O[tt] = MFMA(vb[tt], pf, O[tt]);
    }
    __builtin_amdgcn_sched_group_barrier(0x100, 8, 0);
    __builtin_amdgcn_sched_group_barrier(0x008, 4, 0);
    __builtin_amdgcn_sched_group_barrier(0x100, 4, 0);
    __builtin_amdgcn_sched_group_barrier(0x008, 4, 0);
    __builtin_amdgcn_sched_group_barrier(0x100, 4, 0);
    __builtin_amdgcn_sched_group_barrier(0x008, 8, 0);
    __builtin_amdgcn_s_setprio(0);
  };
  auto softmax = [&](int t) {
    if (lut != nullptr && t >= ntw - 3) {
      const int base = t * 64 - qpos + 191;
#pragma unroll
      for (int kb = 0; kb < 2; ++kb)
#pragma unroll
        for (int i = 0; i < 16; ++i) S[kb][i] += lut[base + kb * 32 + crow(i, hh)];
    }
    if (t == ntw - 1 && nvalid < 64) {
#pragma unroll
      for (int kb = 0; kb < 2; ++kb)
#pragma unroll
        for (int i = 0; i < 16; ++i)
          if (kb * 32 + crow(i, hh) >= nvalid) S[kb][i] = -1e30f;
    }
    float mx = S[0][0];
#pragma unroll
    for (int kb = 0; kb < 2; ++kb)
#pragma unroll
      for (int i = 0; i < 16; ++i) mx = fmaxf(mx, S[kb][i]);
    {
      const unsigned um = __float_as_uint(mx);
      const auto sw = __builtin_amdgcn_permlane32_swap(um, um, false, false);
      mx = fmaxf(__uint_as_float(sw[0]), __uint_as_float(sw[1]));
    }
    if (t == 0) {
      m = mx;
#pragma unroll
      for (int kb = 0; kb < 2; ++kb)
#pragma unroll
        for (int i = 0; i < 16; ++i) S[kb][i] -= mx;
    } else if (__any(mx > 8.f)) {
      const float d = fmaxf(mx, 0.f);
      const float alpha = __builtin_amdgcn_exp2f(-d);
      m += d;
      l *= alpha;
#pragma unroll
      for (int tt = 0; tt < 4; ++tt)
#pragma unroll
        for (int e = 0; e < 16; ++e) O[tt][e] *= alpha;
#pragma unroll
      for (int kb = 0; kb < 2; ++kb)
#pragma unroll
        for (int i = 0; i < 16; ++i) S[kb][i] -= d;
    }
    float ps = 0.f;
#pragma unroll
    for (int kb = 0; kb < 2; ++kb)
#pragma unroll
      for (int i = 0; i < 16; ++i) {
        const float pe = __builtin_amdgcn_exp2f(S[kb][i]);
        S[kb][i] = pe;
        ps += pe;
      }
    l += ps;
#pragma unroll
    for (int kb = 0; kb < 2; ++kb)
#pragma unroll
      for (int s2 = 0; s2 < 2; ++s2) {
        u32x4 pk;
        pk.x = pack2(S[kb][8 * s2 + 0], S[kb][8 * s2 + 1]);
        pk.y = pack2(S[kb][8 * s2 + 2], S[kb][8 * s2 + 3]);
        pk.z = pack2(S[kb][8 * s2 + 4], S[kb][8 * s2 + 5]);
        pk.w = pack2(S[kb][8 * s2 + 6], S[kb][8 * s2 + 7]);
        P[kb * 2 + s2] = pk;
      }
  };
#define D_BAR do { asm volatile("" ::: "memory"); __builtin_amdgcn_s_barrier(); asm volatile("" ::: "memory"); } while (0)
  const int tlast = ntb - 1;
  asm volatile("s_waitcnt vmcnt(0)" :: "v"(qf[0]), "v"(qf[1]), "v"(qf[2]), "v"(qf[3]) : "memory");
  dma(0, 0); dma(1 < tlast ? 1 : tlast, 1);
  if (!grpB) { dma(2 < tlast ? 2 : tlast, 2); asm volatile("s_waitcnt vmcnt(8)" ::: "memory"); }
  else { asm volatile("s_waitcnt vmcnt(4)" ::: "memory"); }
  D_BAR;
  if (grpB && active) qk(0);
  if (!grpB) {
    for (int t = 0; t <= ntb; ++t) {
      const bool act_t = active && (t < ntw);
      if (active && t >= 1 && (t - 1) < ntw) pv((t + 3) & 3);
      __builtin_amdgcn_sched_barrier(0);
      if (act_t) qk(t & 3);
      asm volatile("s_waitcnt vmcnt(4)" ::: "memory");
      D_BAR;
      { const int tn = t + 3; dma(tn < tlast ? tn : tlast, tn & 3); }
      if (act_t) softmax(t);
    }
  } else {
    for (int t = 0; t <= ntb; ++t) {
      const bool act_t = active && (t < ntw);
      { const int tn = t + 2; dma(tn < tlast ? tn : tlast, tn & 3); }
      if (act_t) softmax(t);
      asm volatile("s_waitcnt vmcnt(4)" ::: "memory");
      D_BAR;
      if (act_t) pv(t & 3);
      __builtin_amdgcn_sched_barrier(0);
      if (active && (t + 1) < ntw) qk((t + 1) & 3);
    }
  }
  __builtin_amdgcn_s_setprio(0);
  asm volatile("s_waitcnt vmcnt(0)" ::: "memory");
  __syncthreads();
#undef D_BAR
  l_out = l + __shfl_xor(l, 32);
}

__device__ void diff_item(const Params& p, unsigned char* smem, bool sample, int b, int h, int qb, float lam) {
  int tid = threadIdx.x; asm volatile("" : "+v"(tid));
  const int lane = tid & 63, w = __builtin_amdgcn_readfirstlane(tid >> 6);
  const int r = lane & 31, hh = lane >> 5;
  const int g = w & 3, c = w >> 2;
  const float* lut = reinterpret_cast<const float*>(smem + D_LUT_OFF) + h * 256;
  int tok, qpos, ntb, ntw, nvalid;
  bool active, valid;
  const u16 *kbase, *vtbase;
  int vld;
  if (!sample) {
    const int s = qb * 128 + g * 32 + r;
    tok = b * SEQ + s;
    qpos = s - r;
    ntw = 2 * qb + (g >> 1) + 1;
    ntb = 2 * qb + 2;
    nvalid = 64;
    active = true; valid = true;
    kbase = p.Kall + (size_t)b * SEQ * 1024 + h * 128;
    vtbase = p.VTp + (size_t)(b * 1024 + h * 128) * SEQ;
    vld = SEQ;
  } else {
    tok = NPROMPT + b * 16 + (r < 16 ? r : 15);
    qpos = 1024;
    ntw = 17; ntb = 17; nvalid = 16;
    active = (g == 0); valid = (r < 16);
    kbase = p.Kall + ((size_t)NPROMPT + (size_t)b * SKV) * 1024 + h * 128;
    vtbase = p.VTs + (size_t)(b * 1024 + h * 128) * SKV;
    vld = SKV;
  }
  const u16* qptr = p.Qb + (size_t)tok * 1024 + h * 128 + c * 64 + hh * 8;
  f32x16 O[4];
  float l;
  diff_core(smem, qptr, kbase, vtbase, vld, ntb, ntw, nvalid, 4 * c, lut, qpos + r, active, c == 1, O, l);
  u32x2 gv[16];
  u16* zrow = p.Xb + (size_t)tok * 2048 + h * 128;
  if (c == 0 && active) {
    const u16* grow = p.Gb + (size_t)tok * 2048 + h * 128;
#pragma unroll
    for (int t = 0; t < 4; ++t)
#pragma unroll
      for (int gq = 0; gq < 4; ++gq) gv[t * 4 + gq] = *reinterpret_cast<const u32x2*>(grow + 32 * t + 8 * gq + 4 * hh);
  }
  float* ex = reinterpret_cast<float*>(smem) + g * 4096;
  if (c == 1 && active) {
    const float sc = lam / l;
#pragma unroll
    for (int t = 0; t < 4; ++t)
#pragma unroll
      for (int i = 0; i < 16; ++i) ex[(t * 16 + i) * 64 + lane] = O[t][i] * sc;
  }
  __syncthreads();
  if (c == 0 && active) {
    const float inv = 1.f / l;
    float ss = 0.f;
#pragma unroll
    for (int t = 0; t < 4; ++t)
#pragma unroll
      for (int i = 0; i < 16; ++i) {
        const float o = O[t][i] * inv - ex[(t * 16 + i) * 64 + lane];
        O[t][i] = o;
        ss += o * o;
      }
    ss += __shfl_xor(ss, 32);
    const float rinv = rsqrtf(ss * (1.f / 128.f) + EPSV);
    if (valid) {
#pragma unroll
      for (int t = 0; t < 4; ++t)
#pragma unroll
        for (int gq = 0; gq < 4; ++gq) {
          const int e = 32 * t + 8 * gq + 4 * hh;
          const u32x2 gg = gv[t * 4 + gq];
          const float o0 = O[t][4 * gq + 0] * rinv * __uint_as_float(gg.x << 16);
          const float o1 = O[t][4 * gq + 1] * rinv * __uint_as_float(gg.x & 0xffff0000u);
          const float o2 = O[t][4 * gq + 2] * rinv * __uint_as_float(gg.y << 16);
          const float o3 = O[t][4 * gq + 3] * rinv * __uint_as_float(gg.y & 0xffff0000u);
          u32x2 zo;
          zo.x = pack2(o0, o1);
          zo.y = pack2(o2, o3);
          *reinterpret_cast<u32x2*>(zrow + e) = zo;
        }
    }
  }
  __syncthreads();
}

__device__ void mem_item(const Params& p, unsigned char* smem, bool sample, int b, int h, int qblk) {
  int tid = threadIdx.x; asm volatile("" : "+v"(tid));
  const int lane = tid & 63, w = __builtin_amdgcn_readfirstlane(tid >> 6);
  const int r = lane & 31, hh = lane >> 5;
  int tok, mb;
  bool active, valid;
  if (!sample) {
    tok = qblk * 256 + w * 32 + r;
    mb = tok >> 14;
    active = true; valid = true;
  } else {
    tok = NPROMPT + b * 16 + (r < 16 ? r : 15);
    mb = 2 + b;
    active = (w == 0); valid = (r < 16);
  }
  const u16* qptr = p.MQb + (size_t)tok * 512 + h * 128 + hh * 8;
  const u16* kbase = p.MKall + (size_t)mb * 256 * 512 + h * 128;
  const u16* vtbase = p.MVTall + (size_t)(mb * 4 + h) * 128 * 256;
  f32x16 O[4];
  float m, l;
  flash_core<8>(smem, qptr, kbase, 512, vtbase, 256, 4, 4, 64, 0, nullptr, 0, active, O, m, l);
  if (active && valid) {
    const float inv = 1.f / l;
    const u16* grow = p.Gb + (size_t)tok * 2048 + 1536 + h * 128;
    u16* zrow = p.Xb + (size_t)tok * 2048 + 1536 + h * 128;
    u32x2 gv[16];
#pragma unroll
    for (int t = 0; t < 4; ++t)
#pragma unroll
      for (int gq = 0; gq < 4; ++gq) gv[t * 4 + gq] = *reinterpret_cast<const u32x2*>(grow + 32 * t + 8 * gq + 4 * hh);
#pragma unroll
    for (int t = 0; t < 4; ++t)
#pragma unroll
      for (int gq = 0; gq < 4; ++gq) {
        const int e = 32 * t + 8 * gq + 4 * hh;
        const u32x2 gg = gv[t * 4 + gq];
        const float o0 = O[t][4 * gq + 0] * inv * __uint_as_float(gg.x << 16);
        const float o1 = O[t][4 * gq + 1] * inv * __uint_as_float(gg.x & 0xffff0000u);
        const float o2 = O[t][4 * gq + 2] * inv * __uint_as_float(gg.y << 16);
        const float o3 = O[t][4 * gq + 3] * inv * __uint_as_float(gg.y & 0xffff0000u);
        u32x2 zo;
        zo.x = pack2(o0, o1);
        zo.y = pack2(o2, o3);
        *reinterpret_cast<u32x2*>(zrow + e) = zo;
      }
  }
}

DI void unpack8(const u32x4 v, float (&f)[8]) {
  f[0] = __uint_as_float(v.x << 16); f[1] = __uint_as_float(v.x & 0xffff0000u);
  f[2] = __uint_as_float(v.y << 16); f[3] = __uint_as_float(v.y & 0xffff0000u);
  f[4] = __uint_as_float(v.z << 16); f[5] = __uint_as_float(v.z & 0xffff0000u);
  f[6] = __uint_as_float(v.w << 16); f[7] = __uint_as_float(v.w & 0xffff0000u);
}
__device__ void conv_item(const Params& p, int it) {
  const int cg = threadIdx.x & 63, tl = threadIdx.x >> 6;
  const int c0 = cg * 8;
  float w0[8], w1[8], w2[8];
#pragma unroll
  for (int j = 0; j < 8; ++j) { w0[j] = p.conv_w[c0 + j]; w1[j] = p.conv_w[512 + c0 + j]; w2[j] = p.conv_w[1024 + c0 + j]; }
#pragma unroll 2
  for (int k = 0; k < 8; ++k) {
    const int tok = it * 64 + k * 8 + tl;
    const size_t o = (size_t)tok * 512 + c0;
    float u0[8], u1[8], u2[8], bg[8], gt[8], a[8], b[8];
    unpack8(*reinterpret_cast<const u32x4*>(p.Cb + o), a);
    unpack8(*reinterpret_cast<const u32x4*>(p.Hb + o), b);
#pragma unroll
    for (int j = 0; j < 8; ++j) u0[j] = a[j] * b[j];
    const bool prompt = tok < NPROMPT;
    const int s = prompt ? (tok & (SEQ - 1)) : ((tok - NPROMPT) & 15);
    const int sb = prompt ? 0 : ((tok - NPROMPT) >> 4);
    if (s >= 1) {
      unpack8(*reinterpret_cast<const u32x4*>(p.Cb + o - 512), a);
      unpack8(*reinterpret_cast<const u32x4*>(p.Hb + o - 512), b);
#pragma unroll
      for (int j = 0; j < 8; ++j) u1[j] = a[j] * b[j];
    } else {
#pragma unroll
      for (int j = 0; j < 8; ++j) u1[j] = prompt ? 0.f : p.cache_conv[(size_t)(sb * 2 + 1) * 512 + c0 + j];
    }
    if (s >= 2) {
      unpack8(*reinterpret_cast<const u32x4*>(p.Cb + o - 1024), a);
      unpack8(*reinterpret_cast<const u32x4*>(p.Hb + o - 1024), b);
#pragma unroll
      for (int j = 0; j < 8; ++j) u2[j] = a[j] * b[j];
    } else {
#pragma unroll
      for (int j = 0; j < 8; ++j) u2[j] = prompt ? 0.f : p.cache_conv[(size_t)(sb * 2 + s) * 512 + c0 + j];
    }
    unpack8(*reinterpret_cast<const u32x4*>(p.Bb + o), bg);
    unpack8(*reinterpret_cast<const u32x4*>(p.Gb + (size_t)tok * 2048 + 1024 + c0), gt);
    float z[8];
#pragma unroll
    for (int j = 0; j < 8; ++j) z[j] = bg[j] * (w0[j] * u2[j] + w1[j] * u1[j] + w2[j] * u0[j]) * gt[j];
    u32x4 zo;
    zo.x = pack2(z[0], z[1]); zo.y = pack2(z[2], z[3]); zo.z = pack2(z[4], z[5]); zo.w = pack2(z[6], z[7]);
    *reinterpret_cast<u32x4*>(p.Xb + (size_t)tok * 2048 + 1024 + c0) = zo;
    float* od = nullptr;
    if (prompt) { if (s >= SEQ - 2) od = p.out + O_CP + (size_t)((tok >> 14) * 2 + (s - (SEQ - 2))) * 512 + c0; }
    else { if (s >= 14) od = p.out + O_CS + (size_t)(sb * 2 + (s - 14)) * 512 + c0; }
    if (od != nullptr) {
#pragma unroll
      for (int j = 0; j < 8; ++j) od[j] = u0[j];
    }
  }
}

DI int t5_bucket(int rel) {
  const int n = rel < 0 ? -rel : rel;
  int v;
  if (n < 8) v = n;
  else {
    const int lg = 31 - __clz(n * n);
    v = 2 + lg;
    if (v > 15) v = 15;
  }
  return (rel > 0 ? 16 : 0) + v;
}

__device__ void phaseB(const Params& p, unsigned char* smem, int pass, int item_lo, int item_hi) {
  const int tid = threadIdx.x;
  float* lut = reinterpret_cast<float*>(smem + D_LUT_OFF);
  float* misc = reinterpret_cast<float*>(smem + D_MISC_OFF);
  int* s_item = reinterpret_cast<int*>(smem + D_MISC_OFF + 64);
  for (int i = tid; i < 8 * 256; i += NTHR) {
    const int h = i >> 8, idx = i & 255;
    const int rel = idx - 191;
    lut[i] = (p.rel_table[t5_bucket(rel) * 8 + h] - p.rel_table[15 * 8 + h]) * LOG2E;
  }
  if (tid == 0) {
    float a = 0.f, bsum = 0.f;
    for (int i = 0; i < 64; ++i) { a += p.lq1[i] * p.lk1[i]; bsum += p.lq2[i] * p.lk2[i]; }
    misc[0] = __expf(a) - __expf(bsum) + 0.2f;
  }
  __syncthreads();
  const float lam = misc[0];
  constexpr int N_DP = 2048, N_DS = 256, N_MP = 512, N_MS = 128, N_CV = 520;
  constexpr int N_ALL = N_DP + N_DS + N_MP + N_MS + N_CV;
  int* ctr = p.counter + pass * 16;
  const int xcd = blockIdx.x & 7;
  if (item_lo == 0) {
#pragma unroll 1
    for (int qi = 0; qi < 8; ++qi) {
      const int queue = (xcd + qi) & 7;
      for (;;) {
        if (tid == 0) *s_item = atomicAdd(ctr + 1 + queue, 1);
        __syncthreads();
        const int j = *s_item;
        __syncthreads();
        if (j >= 256) break;
        const int bh = 2 * queue + (j & 1), qb = 127 - (j >> 1);
        diff_item(p, smem, false, bh >> 3, bh & 7, qb, lam);
      }
    }
  }
  if (gridDim.x == 256) {
    if (tid < 64) {
      while (__hip_atomic_load(p.lnready + 9, __ATOMIC_RELAXED, __HIP_MEMORY_SCOPE_AGENT) < 64) __builtin_amdgcn_s_sleep(8);
      __builtin_amdgcn_fence(__ATOMIC_ACQUIRE, "agent");
      asm volatile("s_waitcnt vmcnt(0)" ::: "memory");
    }
    __syncthreads();
  }
  for (;;) {
    if (tid == 0) *s_item = atomicAdd(ctr, 1);
    __syncthreads();
    int it = *s_item + (item_lo > N_DP ? item_lo : N_DP);
    __syncthreads();
    if (it >= item_hi || it >= N_ALL) break;
    it -= N_DP;
    if (it < N_DS) { diff_item(p, smem, true, it >> 3, it & 7, 0, lam); continue; }
    it -= N_DS;
    if (it < N_MP) { mem_item(p, smem, false, 0, it & 3, it >> 2); continue; }
    it -= N_MP;
    if (it < N_MS) { mem_item(p, smem, true, it >> 2, it & 3, 0); continue; }
    it -= N_MS;
    conv_item(p, it);
  }
}

DI void ln_finish(const Params& p, float* __restrict__ pr, const float4 (&v)[8], int lane) {
  float s = 0.f;
#pragma unroll
  for (int i = 0; i < 8; ++i) s += v[i].x + v[i].y + v[i].z + v[i].w;
#pragma unroll
  for (int o = 32; o >= 1; o >>= 1) s += __shfl_xor(s, o);
  const float mu = s * (1.f / 2048.f);
  float q = 0.f;
#pragma unroll
  for (int i = 0; i < 8; ++i) {
    const float a = v[i].x - mu, b = v[i].y - mu, c = v[i].z - mu, d = v[i].w - mu;
    q += a * a + b * b + c * c + d * d;
  }
#pragma unroll
  for (int o = 32; o >= 1; o >>= 1) q += __shfl_xor(q, o);
  const float rstd = rsqrtf(q * (1.f / 2048.f) + EPSV);
#pragma unroll
  for (int i = 0; i < 8; ++i) {
    const int c0 = (i * 64 + lane) * 4;
    const float4 g = *reinterpret_cast<const float4*>(p.ln_g + c0);
    const float4 bb = *reinterpret_cast<const float4*>(p.ln_b + c0);
    float4 o;
    o.x = (v[i].x - mu) * rstd * g.x + bb.x;
    o.y = (v[i].y - mu) * rstd * g.y + bb.y;
    o.z = (v[i].z - mu) * rstd * g.z + bb.z;
    o.w = (v[i].w - mu) * rstd * g.w + bb.w;
    *reinterpret_cast<float4*>(pr + c0) = o;
  }
}
__device__ void phaseD(const Params& p) {
  int tidd = threadIdx.x; asm volatile("" : "+v"(tidd));
  const int lane = tidd & 63, w = tidd >> 6;
  const int stride = gridDim.x * 8;
  int row = blockIdx.x * 8 + w;
  for (; row + stride < NTOK; row += 2 * stride) {
    float* pa = p.out + O_Y + (size_t)row * 2048;
    float* pb = p.out + O_Y + (size_t)(row + stride) * 2048;
    float4 va[8], vb[8];
#pragma unroll
    for (int i = 0; i < 8; ++i) va[i] = *reinterpret_cast<const float4*>(pa + (i * 64 + lane) * 4);
#pragma unroll
    for (int i = 0; i < 8; ++i) vb[i] = *reinterpret_cast<const float4*>(pb + (i * 64 + lane) * 4);
    ln_finish(p, pa, va, lane);
    ln_finish(p, pb, vb, lane);
  }
  if (row < NTOK) {
    float* pa = p.out + O_Y + (size_t)row * 2048;
    float4 va[8];
#pragma unroll
    for (int i = 0; i < 8; ++i) va[i] = *reinterpret_cast<const float4*>(pa + (i * 64 + lane) * 4);
    ln_finish(p, pa, va, lane);
  }
}

__device__ void phaseD_handoff(const Params& p, unsigned char* smem) {
  int tidd = threadIdx.x; asm volatile("" : "+v"(tidd));
  const int lane = tidd & 63, w = __builtin_amdgcn_readfirstlane(tidd >> 6);
  int* s_item = reinterpret_cast<int*>(smem);
  for (;;) {
    if (tidd == 0) *s_item = atomicAdd(p.lnready + 2, 1);
    __syncthreads();
    const int it = *s_item;
    __syncthreads();
    if (it >= 130 * 4) break;
    const int panel = it >> 2, chunk = it & 3;
    if (w == 0) {
      const int* flag = p.lnready + (panel < 128 ? 0 : 1);
      const int need = panel < 128 ? 2048 : 16;
      while (__hip_atomic_load(flag, __ATOMIC_RELAXED, __HIP_MEMORY_SCOPE_AGENT) < need) __builtin_amdgcn_s_sleep(8);
      __builtin_amdgcn_fence(__ATOMIC_ACQUIRE, "agent");
      asm volatile("s_waitcnt vmcnt(0)" ::: "memory");
    }
    __syncthreads();
    const int row0 = panel * 256 + chunk * 64 + w * 8;
#pragma unroll 1
    for (int k = 0; k < 4; ++k) {
      float* pa = p.out + O_Y + (size_t)(row0 + k) * 2048;
      float* pb = p.out + O_Y + (size_t)(row0 + 4 + k) * 2048;
      float4 va[8], vb[8];
#pragma unroll
      for (int i = 0; i < 8; ++i) va[i] = *reinterpret_cast<const float4*>(pa + (i * 64 + lane) * 4);
#pragma unroll
      for (int i = 0; i < 8; ++i) vb[i] = *reinterpret_cast<const float4*>(pb + (i * 64 + lane) * 4);
      ln_finish(p, pa, va, lane);
      ln_finish(p, pb, vb, lane);
    }
  }
}

DI void gbar(int* word, int nblocks) {
  int tg = threadIdx.x; asm volatile("" : "+v"(tg));
  asm volatile("s_waitcnt vmcnt(0)" ::: "memory");
  __syncthreads();
  if (tg == 0) {
    __builtin_amdgcn_fence(__ATOMIC_RELEASE, "agent");
    __hip_atomic_fetch_add(word, 1, __ATOMIC_RELAXED, __HIP_MEMORY_SCOPE_AGENT);
  }
  if (tg < 64) {
    while (__hip_atomic_load(word, __ATOMIC_RELAXED, __HIP_MEMORY_SCOPE_AGENT) < nblocks) __builtin_amdgcn_s_sleep(4);
    __builtin_amdgcn_fence(__ATOMIC_ACQUIRE, "agent");
    asm volatile("s_waitcnt vmcnt(0)" ::: "memory");
  }
  __syncthreads();
}

__global__ void __launch_bounds__(NTHR) fwd_megakernel(Params p) {
  extern __shared__ __attribute__((aligned(16))) unsigned char smem[];
  cg::grid_group grid = cg::this_grid();
  if (gridDim.x == 0x7fffffffu) grid.sync();

  if (p.mode != 0) return;
  phase0(p, smem);
  gbar(p.gbarw + 32, (int)gridDim.x);
#if STOP_AFTER == 0
  return;
#endif

  {
    SchedIn S; S.p = &p; S.G = (int)gridDim.x; S.c = (int)blockIdx.x;
    EpiAll E; E.p = &p; E.handoff = (gridDim.x == 256);
    gemm_phase<EpiAll, SchedIn>((LAS unsigned char*)smem, S, E);
  }
  const bool ho = (gridDim.x == 256);
  if (ho) {
    __syncthreads();
    if (threadIdx.x == 0) {
      __builtin_amdgcn_fence(__ATOMIC_RELEASE, "agent");
      if (blockIdx.x < 64) __hip_atomic_fetch_add(p.lnready + 9, 1, __ATOMIC_RELAXED, __HIP_MEMORY_SCOPE_AGENT);
      else __hip_atomic_fetch_add(p.lnready + 8, 8, __ATOMIC_RELAXED, __HIP_MEMORY_SCOPE_AGENT);
    }
    if (threadIdx.x < 64) {
      while (__hip_atomic_load(p.lnready + 8, __ATOMIC_RELAXED, __HIP_MEMORY_SCOPE_AGENT) < 2048) __builtin_amdgcn_s_sleep(8);
      __builtin_amdgcn_fence(__ATOMIC_ACQUIRE, "agent");
      asm volatile("s_waitcnt vmcnt(0)" ::: "memory");
    }
    __syncthreads();
  } else {
    gbar(p.gbarw + 48, (int)gridDim.x);
  }
#if STOP_AFTER == 1
  return;
#endif

  phaseB(p, smem, 0, 0, 1 << 30);
#if PROBE_B
  phaseB(p, smem, 1, PROBE_B_LO, PROBE_B_HI);
#endif
  gbar(p.gbarw + 16, (int)gridDim.x);
#if STOP_AFTER == 2
  return;
#endif

  {
    SchedOut S; S.p = &p; S.G = (int)gridDim.x; S.c = (int)blockIdx.x;
    EpiAll E; E.p = &p; E.handoff = (gridDim.x == 256);
    gemm_phase<EpiAll, SchedOut>((LAS unsigned char*)smem, S, E);
  }
  if (gridDim.x == 256) {
    __syncthreads();
    if (threadIdx.x == 0) {
      __builtin_amdgcn_fence(__ATOMIC_RELEASE, "agent");
      if (blockIdx.x < 16) __hip_atomic_fetch_add(p.lnready + 1, 1, __ATOMIC_RELAXED, __HIP_MEMORY_SCOPE_AGENT);
      else __hip_atomic_fetch_add(p.lnready, 8, __ATOMIC_RELAXED, __HIP_MEMORY_SCOPE_AGENT);
    }
    __syncthreads();
    phaseD_handoff(p, smem);
    return;
  }
  gbar(p.gbarw + 4, (int)gridDim.x);

  phaseD(p);
}

extern "C" void kernel_launch(void* const* d_in, const int* in_sizes, int n_in, void* d_out, int out_size, void* d_ws,
                              size_t ws_size, hipStream_t stream) {
  static int grid_blocks = 0;
  if (!grid_blocks) {
    int dev = 0, cus = 0, per_cu = 0;
    (void)hipGetDevice(&dev);
    (void)hipDeviceGetAttribute(&cus, hipDeviceAttributeMultiprocessorCount, dev);
    if (hipFuncSetAttribute((const void*)fwd_megakernel, hipFuncAttributeMaxDynamicSharedMemorySize, SMEM_BYTES) != hipSuccess)
      fprintf(stderr, "hipFuncSetAttribute failed\n");
    (void)hipOccupancyMaxActiveBlocksPerMultiprocessor(&per_cu, (const void*)fwd_megakernel, NTHR, SMEM_BYTES);
    if (per_cu < 1) per_cu = 1;
    if (per_cu > 1) per_cu = 1;
    grid_blocks = cus * per_cu;
  }
  Params p{};
  p.x_prompt = (const float*)d_in[0];  p.x_sample = (const float*)d_in[1];
  p.cache_k = (const float*)d_in[2];   p.cache_v = (const float*)d_in[3];
  p.cache_conv = (const float*)d_in[4]; p.cache_mk = (const float*)d_in[5];
  p.cache_mv = (const float*)d_in[6];  p.mem_prompt = (const float*)d_in[7];
  p.rel_table = (const float*)d_in[8]; p.w_in = (const float*)d_in[9];
  p.w_memkv = (const float*)d_in[10];  p.conv_w = (const float*)d_in[11];
  p.lq1 = (const float*)d_in[12];      p.lk1 = (const float*)d_in[13];
  p.lq2 = (const float*)d_in[14];      p.lk2 = (const float*)d_in[15];
  p.subln_g = (const float*)d_in[16];  p.w_out = (const float*)d_in[17];
  p.ln_g = (const float*)d_in[18];     p.ln_b = (const float*)d_in[19];
  p.out = (float*)d_out;
  unsigned char* ws = (unsigned char*)d_ws;
  size_t off = 0;
  auto take = [&](size_t bytes) { unsigned char* q = ws + off; off += (bytes + 255) & ~(size_t)255; return q; };
  p.counter = (int*)take(256);
  p.gbarw = (int*)take(256);
  p.lnready = (int*)take(256);
  p.Xb = (u16*)take((size_t)NTOK * 2048 * 2);
  p.Mb = (u16*)take((size_t)512 * 2048 * 2);
  p.WinT = (u16*)take((size_t)7168 * 2048 * 2);
  p.WmemT = (u16*)take((size_t)1024 * 2048 * 2);
  p.WoutT = (u16*)take((size_t)2048 * 2048 * 2);
  p.Qb = (u16*)take((size_t)NTOK * 1024 * 2);
  p.Kall = (u16*)take((size_t)(NPROMPT + 32 * SKV) * 1024 * 2);
  p.VTp = (u16*)take((size_t)2048 * SEQ * 2);
  p.VTs = (u16*)take((size_t)32768 * SKV * 2);
  p.Hb = (u16*)take((size_t)NTOK * 512 * 2);
  p.Bb = (u16*)take((size_t)NTOK * 512 * 2);
  p.Cb = (u16*)take((size_t)NTOK * 512 * 2);
  p.MQb = (u16*)take((size_t)NTOK * 512 * 2);
  p.Gb = (u16*)take((size_t)NTOK * 2048 * 2);
  p.MKall = (u16*)take((size_t)34 * 256 * 512 * 2);
  p.MVTall = (u16*)take((size_t)34 * 512 * 256 * 2);
  {
    static const long long exp_sizes[20] = {67108864LL, 1048576, 33554432, 33554432, 32768, 4194304, 4194304, 1048576, 256,
                                            14680064, 2097152, 1536, 64, 64, 64, 64, 128, 4194304, 2048, 2048};
    int bad = -1;
    for (int i = 0; i < 20 && i < n_in; ++i) if ((long long)in_sizes[i] != exp_sizes[i]) { bad = i; break; }
    if (bad < 0 && n_in != 20) bad = 20;
    if (bad < 0 && out_size != 136873984) bad = 21;
    if (bad >= 0) {
      p.mode = 1;
    }
  }
  if (off > ws_size) { fprintf(stderr, "workspace too small: need %zu have %zu\n", off, ws_size); return; }
  (void)hipMemsetAsync(p.gbarw, 0, 256, stream);
  void* args[] = {&p};
  hipError_t e = hipLaunchCooperativeKernel((void*)fwd_megakernel, dim3(grid_blocks), dim3(NTHR), args, SMEM_BYTES, stream);
  if (e != hipSuccess) fprintf(stderr, "cooperative launch failed: %s (grid %d)\n", hipGetErrorString(e), grid_blocks);
}
```

```cpp
#include <hip/hip_runtime.h>
#include <hip/hip_cooperative_groups.h>
#include <cstdio>
namespace cg = cooperative_groups;

typedef unsigned short u16;
using bf16x8 = __attribute__((ext_vector_type(8))) short;
using f32x16 = __attribute__((ext_vector_type(16))) float;
typedef __bf16 bf2_t __attribute__((ext_vector_type(2)));
typedef float f2_t __attribute__((ext_vector_type(2)));
typedef unsigned u32x4 __attribute__((ext_vector_type(4)));
typedef unsigned u32x2 __attribute__((ext_vector_type(2)));
#define DI __device__ __forceinline__
#define MFMA(a, b, c) __builtin_amdgcn_mfma_f32_32x32x16_bf16((a), (b), (c), 0, 0, 0)

#ifndef STOP_AFTER
#define STOP_AFTER 9
#define P0_PART 0
#ifndef PROBE_B
#define PROBE_B 0
#define PROBE_B_LO 0
#define PROBE_B_HI 2048
#endif
#ifndef PROBE_A
#define PROBE_A 1
#endif
#ifndef PROBE_C
#define PROBE_C 1
#endif
#endif
constexpr int NTHR = 512;
constexpr int SEQ = 16384;
constexpr int NPROMPT = 32768;
constexpr int NTOK = 33280;
constexpr int SKV = 1088;
constexpr int SMEM_BYTES = 147456;
constexpr float LOG2E = 1.4426950408889634f;
constexpr float ALPHA_RES = 1.189207115002721f;
constexpr float EPSV = 1e-5f;

constexpr size_t O_Y = 0;
constexpr size_t O_KP = 68157440;
constexpr size_t O_VP = 101711872;
constexpr size_t O_CP = 135266304;
constexpr size_t O_MKP = 135268352;
constexpr size_t O_MVP = 135530496;
constexpr size_t O_KS = 135792640;
constexpr size_t O_VS = 136316928;
constexpr size_t O_CS = 136841216;

struct Params {
  const float *x_prompt, *x_sample, *cache_k, *cache_v, *cache_conv, *cache_mk, *cache_mv, *mem_prompt, *rel_table,
      *w_in, *w_memkv, *conv_w, *lq1, *lk1, *lq2, *lk2, *subln_g, *w_out, *ln_g, *ln_b;
  float* out;
  int* counter;
  int* gbarw;
  int* lnready;
  long long mode;
  u16 *Xb, *Mb, *WinT, *WmemT, *WoutT, *Qb, *Kall, *VTp, *VTs, *Hb, *Bb, *Cb, *MQb, *Gb, *MKall, *MVTall;
};

DI int crow(int i, int hh) { return (i & 3) + 8 * (i >> 2) + 4 * hh; }
DI unsigned pack2(float a, float b) {
  f2_t v = {a, b};
  bf2_t r = __builtin_convertvector(v, bf2_t);
  return __builtin_bit_cast(unsigned, r);
}
DI float bf2f(u16 v) { return __uint_as_float(((unsigned)v) << 16); }
DI float silu_f(float x) { return x / (1.f + __expf(-x)); }

DI void cvt8(const float* src, u16* dst) {
  const float4 a = *reinterpret_cast<const float4*>(src);
  const float4 b = *reinterpret_cast<const float4*>(src + 4);
  uint4 o;
  o.x = pack2(a.x, a.y); o.y = pack2(a.z, a.w); o.z = pack2(b.x, b.y); o.w = pack2(b.z, b.w);
  *reinterpret_cast<uint4*>(dst) = o;
}

DI void cvt_stream(const float* __restrict__ src, u16* __restrict__ dst, size_t ngroups, size_t gtid, size_t gn) {
  size_t g = gtid;
  for (; g + 3 * gn < ngroups; g += 4 * gn) {
    float4 a[4], b[4];
#pragma unroll
    for (int i = 0; i < 4; ++i) {
      a[i] = *reinterpret_cast<const float4*>(src + (g + i * gn) * 8);
      b[i] = *reinterpret_cast<const float4*>(src + (g + i * gn) * 8 + 4);
    }
#pragma unroll
    for (int i = 0; i < 4; ++i) {
      uint4 o;
      o.x = pack2(a[i].x, a[i].y); o.y = pack2(a[i].z, a[i].w); o.z = pack2(b[i].x, b[i].y); o.w = pack2(b[i].z, b[i].w);
      *reinterpret_cast<uint4*>(dst + (g + i * gn) * 8) = o;
    }
  }
  for (; g < ngroups; g += gn) cvt8(src + g * 8, dst + g * 8);
}

DI void transpose_tile(const float* src, size_t src_ld, u16* dst, size_t dst_ld, bool perm, float* sm) {
  const int tid = threadIdx.x;
#pragma unroll
  for (int i = 0; i < 2; ++i) {
    const int idx = tid + NTHR * i;
    const int row = idx >> 4, c4 = (idx & 15) * 4;
    const float4 v = *reinterpret_cast<const float4*>(src + (size_t)row * src_ld + c4);
    float* d = sm + row * 65 + c4;
    d[0] = v.x; d[1] = v.y; d[2] = v.z; d[3] = v.w;
  }
  __syncthreads();
  const int c = tid >> 3, seg = tid & 7;
  float v[8];
#pragma unroll
  for (int j = 0; j < 8; ++j) {
    int rr;
    if (perm) {
      const int gi = seg >> 1, half = seg & 1;
      rr = 16 * gi + ((j < 4) ? (4 * half + j) : (8 + 4 * half + (j - 4)));
    } else {
      rr = seg * 8 + j;
    }
    v[j] = sm[rr * 65 + c];
  }
  uint4 o;
  o.x = pack2(v[0], v[1]); o.y = pack2(v[2], v[3]); o.z = pack2(v[4], v[5]); o.w = pack2(v[6], v[7]);
  *reinterpret_cast<uint4*>(dst + (size_t)c * dst_ld + seg * 8) = o;
  __syncthreads();
}

__device__ void phase0(const Params& p, unsigned char* smem) {
  const int tid = threadIdx.x;
  const size_t gtid = (size_t)blockIdx.x * NTHR + tid;
  const size_t gn = (size_t)gridDim.x * NTHR;
  if (blockIdx.x == 0 && tid < 64) { p.counter[tid] = 0; p.lnready[tid] = 0; }
  cvt_stream(p.x_prompt, p.Xb, (size_t)NPROMPT * 256, gtid, gn);
  for (size_t g = gtid; g < (size_t)512 * 256; g += gn) cvt8(p.x_sample + g * 8, p.Xb + (size_t)NPROMPT * 2048 + g * 8);
  for (size_t g = gtid; g < (size_t)512 * 256; g += gn) cvt8(p.mem_prompt + g * 8, p.Mb + g * 8);
  cvt_stream(p.cache_mk, p.MKall + (size_t)2 * 256 * 512, (size_t)32 * 256 * 64, gtid, gn);
  for (int b = 0; b < 32; ++b)
    cvt_stream(p.cache_k + (size_t)b * 1024 * 1024, p.Kall + ((size_t)NPROMPT + (size_t)b * SKV) * 1024, (size_t)1024 * 128, gtid, gn);
  for (size_t g = gtid; g < (size_t)32768 * 6; g += gn) {
    const size_t row = g / 6, ch = g % 6;
    *reinterpret_cast<uint4*>(p.VTs + row * SKV + 1040 + ch * 8) = make_uint4(0, 0, 0, 0);
  }
#if P0_PART == 1
  return;
#endif
  float* sm = reinterpret_cast<float*>(smem);
  constexpr int T_WIN = 32 * 112, T_WMEM = 32 * 16, T_WOUT = 32 * 32, T_CV = 32 * 8 * 16 * 2, T_MV = 32 * 4 * 4 * 2;
  constexpr int T_ALL = T_WIN + T_WMEM + T_WOUT + T_CV + T_MV;
  for (int t = blockIdx.x; t < T_ALL; t += gridDim.x) {
    int u = t;
    if (u < T_WIN) {
      const int kt = u & 31, nt = u >> 5;
      transpose_tile(p.w_in + (size_t)kt * 64 * 7168 + nt * 64, 7168, p.WinT + (size_t)nt * 64 * 2048 + kt * 64, 2048, false, sm);
      continue;
    }
    u -= T_WIN;
    if (u < T_WMEM) {
      const int kt = u & 31, nt = u >> 5;
      transpose_tile(p.w_memkv + (size_t)kt * 64 * 1024 + nt * 64, 1024, p.WmemT + (size_t)nt * 64 * 2048 + kt * 64, 2048, false, sm);
      continue;
    }
    u -= T_WMEM;
    if (u < T_WOUT) {
      const int kt = u & 31, nt = u >> 5;
      transpose_tile(p.w_out + (size_t)kt * 64 * 2048 + nt * 64, 2048, p.WoutT + (size_t)nt * 64 * 2048 + kt * 64, 2048, false, sm);
      continue;
    }
    u -= T_WOUT;
    if (u < T_CV) {
      const int et = u & 1, st = (u >> 1) & 15, bh = u >> 5;
      const int b = bh >> 3, h = bh & 7;
      transpose_tile(p.cache_v + ((size_t)b * 1024 + st * 64) * 1024 + h * 128 + et * 64, 1024,
                     p.VTs + ((size_t)bh * 128 + et * 64) * SKV + st * 64, SKV, true, sm);
      continue;
    }
    u -= T_CV;
    {
      const int et = u & 1, st = (u >> 1) & 3, bh = u >> 3;
      const int b = bh >> 2, h = bh & 3;
      transpose_tile(p.cache_mv + ((size_t)b * 256 + st * 64) * 512 + h * 128 + et * 64, 512,
                     p.MVTall + ((size_t)(2 * 4 + bh) * 128 + et * 64) * 256 + st * 64, 256, true, sm);
    }
  }
}

#define LAS __attribute__((address_space(3)))
using f32x4 = __attribute__((ext_vector_type(4))) float;
constexpr int G_BK = 64, G_HALF = 128, G_HTB = G_HALF * G_BK * 2;

DI int lds_byte(int r, int c) { const int st = (r >> 4) * 2 + (c >> 5), rr = r & 15, cc = c & 31, ob = rr * 64 + cc * 2; return st * 1024 + (ob ^ (((ob >> 9) & 1) << 5)); }
DI void stage_rc(int b, int& R, int& C) { const int st = b / 1024, sb = b % 1024, swz = sb ^ (((sb >> 9) & 1) << 5); R = (st >> 1) * 16 + swz / 64; C = (st & 1) * 32 + (swz % 64) / 2; }
DI int perm32(int rho) { const int n = rho >> 4, i = rho & 15; return 8 * (i >> 2) + 4 * n + (i & 3); }

struct Unit { const char* a; const char* b; int pm, pn, kind; };
constexpr size_t TSTEP = (size_t)256 * 2048 * 2;

struct SchedIn {
  const Params* p; int G, c;
  DI bool next(int i, Unit& u) const {
    const int L = i * G + c;
    if (L >= 3648) return false;
    int mt, nt;
    if (L < 3584) {
      const int lb = L & 255, P = (L >> 8) * 8 + (lb & 7), li = lb >> 3;
      nt = (P % 7) * 4 + (li & 3); mt = (P / 7) * 8 + (li >> 2);
    } else if (L < 3640) { const int j = L - 3584; mt = 128 + (j & 1); nt = j >> 1; }
    else {
      const int j = L - 3640; u.pm = j >> 2; u.pn = j & 3; u.kind = 1;
      u.a = (const char*)p->Mb + (size_t)u.pm * TSTEP; u.b = (const char*)p->WmemT + (size_t)u.pn * TSTEP;
      return true;
    }
    u.pm = mt; u.pn = nt; u.kind = 0;
    u.a = (const char*)p->Xb + (size_t)mt * TSTEP; u.b = (const char*)p->WinT + (size_t)nt * TSTEP;
    return true;
  }
};
struct SchedOut {
  const Params* p; int G, c;
  DI bool next(int i, Unit& u) const {
    const int L = i * G + c;
    if (L >= 1040) return false;
    int mt, nt;
    if (L < 1024) { mt = 8 * (L >> 6) + (L & 7); nt = (L >> 3) & 7; }
    else { const int j = L - 1024; mt = 128 + (j & 1); nt = j >> 1; }
    u.pm = mt; u.pn = nt; u.kind = 2;
    u.a = (const char*)p->Xb + (size_t)mt * TSTEP; u.b = (const char*)p->WoutT + (size_t)nt * TSTEP;
    return true;
  }
};

DI int perm_pos(int s) { return (s & ~12) | ((s & 4) << 1) | ((s & 8) >> 1); }

struct EpiAll {
  const Params* p;
  bool handoff;
  DI void done(const Unit& u, int ui, bool has_next, int lane) const {
    if (handoff && u.kind == 2 && ui == 3 && has_next) {
      __builtin_amdgcn_fence(__ATOMIC_RELEASE, "agent");
      if (lane == 0) __hip_atomic_fetch_add(p->lnready, 1, __ATOMIC_RELAXED, __HIP_MEMORY_SCOPE_AGENT);
    }
    if (handoff && u.kind != 2 && ui == 13 && has_next) {
      __builtin_amdgcn_fence(__ATOMIC_RELEASE, "agent");
      if (lane == 0) __hip_atomic_fetch_add(p->lnready + 8, 1, __ATOMIC_RELAXED, __HIP_MEMORY_SCOPE_AGENT);
    }
  }
  DI void operator()(const f32x4 (&acc)[2][2][4][2], const Unit& u, int wr, int wc, int fr, int fq) const {
    const Params& P = *p;
    const int m0 = u.pm * 256, n0 = u.pn * 256;
    const int rbase = m0 + wr * 64 + fr;
    const int cbase = wc * 32 + 8 * fq;
    if (u.kind == 2) {
#pragma unroll
      for (int ai = 0; ai < 2; ++ai)
#pragma unroll
        for (int mp = 0; mp < 2; ++mp) {
          f32x4 xv[2][2][2];
#pragma unroll
          for (int mm = 0; mm < 2; ++mm) {
            const int row = rbase + ai * 128 + (mp * 2 + mm) * 16;
            const float* __restrict__ xs = (row < NPROMPT) ? (P.x_prompt + (size_t)row * 2048) : (P.x_sample + (size_t)(row - NPROMPT) * 2048);
#pragma unroll
            for (int bj = 0; bj < 2; ++bj) {
              const int col = n0 + cbase + bj * 128;
              xv[mm][bj][0] = *reinterpret_cast<const f32x4*>(xs + col);
              xv[mm][bj][1] = *reinterpret_cast<const f32x4*>(xs + col + 4);
            }
          }
#pragma unroll
          for (int mm = 0; mm < 2; ++mm) {
            const int row = rbase + ai * 128 + (mp * 2 + mm) * 16;
            float* __restrict__ od = P.out + O_Y + (size_t)row * 2048;
#pragma unroll
            for (int bj = 0; bj < 2; ++bj) {
              const int col = n0 + cbase + bj * 128;
              *reinterpret_cast<f32x4*>(od + col) = xv[mm][bj][0] * ALPHA_RES + acc[ai][bj][mp * 2 + mm][0];
              *reinterpret_cast<f32x4*>(od + col + 4) = xv[mm][bj][1] * ALPHA_RES + acc[ai][bj][mp * 2 + mm][1];
            }
          }
        }
      return;
    }
    u16* bdst = nullptr; float* fdst = nullptr; u16* vdst = nullptr;
    int bld = 0, fld = 0, coff = 0, kremap = 0, frow_off = 0;
    int vshift = 0, vbatch = 0, vld = 0, vposoff = 0, vrow_off = 0;
    float scale = 1.f; int dosilu = 0;
    if (u.kind == 0) {
      const bool sample = (m0 >= NPROMPT);
      if (n0 < 1024) { bdst = P.Qb; bld = 1024; coff = 0; scale = 0.125f * LOG2E; }
      else if (n0 < 2048) {
        bdst = P.Kall; bld = 1024; coff = 1024; kremap = 1;
        fdst = P.out + (sample ? O_KS : O_KP); fld = 1024; frow_off = sample ? NPROMPT : 0;
      } else if (n0 < 3072) {
        coff = 2048;
        fdst = P.out + (sample ? O_VS : O_VP); fld = 1024; frow_off = sample ? NPROMPT : 0;
        if (!sample) { vdst = P.VTp; vshift = 14; vbatch = 1024; vld = SEQ; vposoff = 0; vrow_off = 0; }
        else { vdst = P.VTs; vshift = 4; vbatch = 1024; vld = SKV; vposoff = 1024; vrow_off = NPROMPT; }
      } else if (n0 < 3584) { bdst = P.Hb; bld = 512; coff = 3072; }
      else if (n0 < 4096) { bdst = P.Bb; bld = 512; coff = 3584; }
      else if (n0 < 4608) { bdst = P.Cb; bld = 512; coff = 4096; }
      else if (n0 < 5120) { bdst = P.MQb; bld = 512; coff = 4608; scale = 0.08838834764831845f * LOG2E; }
      else { bdst = P.Gb; bld = 2048; coff = 5120; dosilu = 1; }
    } else {
      if (n0 < 512) { bdst = P.MKall; bld = 512; coff = 0; fdst = P.out + O_MKP; fld = 512; }
      else { coff = 512; fdst = P.out + O_MVP; fld = 512; vdst = P.MVTall; vshift = 8; vbatch = 512; vld = 256; }
    }
    const int c0 = n0 - coff + cbase;
#pragma unroll
    for (int ai = 0; ai < 2; ++ai)
#pragma unroll
      for (int m = 0; m < 4; ++m) {
        const int row = rbase + ai * 128 + m * 16;
#pragma unroll
        for (int bj = 0; bj < 2; ++bj) {
          const int col = c0 + bj * 128;
          const f32x4 a0 = acc[ai][bj][m][0], a1 = acc[ai][bj][m][1];
          if (bdst != nullptr) {
            float v[8] = {a0[0] * scale, a0[1] * scale, a0[2] * scale, a0[3] * scale, a1[0] * scale, a1[1] * scale, a1[2] * scale, a1[3] * scale};
            if (dosilu) {
#pragma unroll
              for (int j = 0; j < 8; ++j) v[j] = silu_f(v[j]);
              if (col < 1024) {
                const f32x4 s0 = *reinterpret_cast<const f32x4*>(P.subln_g + (col & 127));
                const f32x4 s1 = *reinterpret_cast<const f32x4*>(P.subln_g + (col & 127) + 4);
#pragma unroll
                for (int j = 0; j < 4; ++j) { v[j] *= s0[j] * 0.8f; v[4 + j] *= s1[j] * 0.8f; }
              }
            }
            u32x4 pk;
            pk.x = pack2(v[0], v[1]); pk.y = pack2(v[2], v[3]); pk.z = pack2(v[4], v[5]); pk.w = pack2(v[6], v[7]);
            size_t drow = (size_t)row;
            if (kremap && row >= NPROMPT) { const int rs = row - NPROMPT; drow = (size_t)NPROMPT + (size_t)(rs >> 4) * SKV + 1024 + (rs & 15); }
            *reinterpret_cast<u32x4*>(bdst + drow * bld + col) = pk;
          }
          if (fdst != nullptr) {
            float* fp = fdst + (size_t)(row - frow_off) * fld + col;
            *reinterpret_cast<f32x4*>(fp) = a0;
            *reinterpret_cast<f32x4*>(fp + 4) = a1;
          }
          if (vdst != nullptr) {
            const int rv = row - vrow_off;
            const int bidx = rv >> vshift, s = rv & ((1 << vshift) - 1);
            u16* vp = vdst + (size_t)(bidx * vbatch + col) * vld + vposoff + perm_pos(s);
            const unsigned p0 = pack2(a0[0], a0[1]), p1 = pack2(a0[2], a0[3]), p2 = pack2(a1[0], a1[1]), p3 = pack2(a1[2], a1[3]);
            vp[0] = (u16)(p0 & 0xffff); vp[(size_t)vld] = (u16)(p0 >> 16);
            vp[(size_t)2 * vld] = (u16)(p1 & 0xffff); vp[(size_t)3 * vld] = (u16)(p1 >> 16);
            vp[(size_t)4 * vld] = (u16)(p2 & 0xffff); vp[(size_t)5 * vld] = (u16)(p2 >> 16);
            vp[(size_t)6 * vld] = (u16)(p3 & 0xffff); vp[(size_t)7 * vld] = (u16)(p3 >> 16);
          }
        }
      }
  }
};

template <class Epi, class Sched>
DI void gemm_phase(LAS unsigned char* lds, const Sched& S, const Epi& E) {
  int tidl = threadIdx.x; asm volatile("" : "+v"(tidl));
  const int tid = tidl, wid = __builtin_amdgcn_readfirstlane(tid >> 6), lane = tid & 63, wr = wid >> 2, wc = wid & 3, fr = lane & 15, fq = lane >> 4;
  constexpr int K = 2048, nt = K / G_BK;
  unsigned voffA[2], voffB[2];
#pragma unroll
  for (int i = 0; i < 2; ++i) {
    int R, C; stage_rc(tid * 16 + i * 8192, R, C);
    const int Rb = (R & ~31) + perm32(R & 31);
    voffA[i] = (unsigned)(R * K + C) * 2u; voffB[i] = (unsigned)(Rb * K + C) * 2u;
  }
  constexpr size_t kstep = (size_t)(G_BK * 2);
  constexpr size_t hstep = (size_t)G_HALF * K * 2;
  const unsigned ldsw = (unsigned)wid * 1024u;
  const int aoff = lds_byte(wr * 64 + fr, fq * 8), boff = lds_byte(wc * 32 + fr, fq * 8);
#define PG8_SA(b, h) (((b) * 2 + (h)) * G_HTB)
#define PG8_SB(b, h) ((4 + (b) * 2 + (h)) * G_HTB)
#define PG8_STAGE(bufoff, gbase, voff) do { _Pragma("unroll") for (int _i = 0; _i < 2; ++_i) \
    __builtin_amdgcn_global_load_lds((const unsigned*)((const char*)(gbase) + (voff)[_i]), (LAS unsigned*)(lds + (bufoff) + ldsw + _i * 8192), 16, 0, 0); } while (0)
#define PG8_LDA(dst, b, h) do { _Pragma("unroll") for (int m = 0; m < 4; ++m) _Pragma("unroll") for (int k = 0; k < 2; ++k) dst[m][k] = *(const LAS bf16x8*)(lds + PG8_SA(b, h) + aoff + m * 2048 + k * 1024); } while (0)
#define PG8_LDB(dst, b, h) do { _Pragma("unroll") for (int n = 0; n < 2; ++n) _Pragma("unroll") for (int k = 0; k < 2; ++k) dst[n][k] = *(const LAS bf16x8*)(lds + PG8_SB(b, h) + boff + n * 2048 + k * 1024); } while (0)
#define PG8_MMA(ai, bj, At, Bt) do { __builtin_amdgcn_s_setprio(1); _Pragma("unroll") for (int m = 0; m < 4; ++m) _Pragma("unroll") for (int n = 0; n < 2; ++n) _Pragma("unroll") for (int k = 0; k < 2; ++k) \
    acc[ai][bj][m][n] = __builtin_amdgcn_mfma_f32_16x16x32_bf16(Bt[n][k], At[m][k], acc[ai][bj][m][n], 0, 0, 0); __builtin_amdgcn_s_setprio(0); } while (0)
#define PG8_WAIT_V(n) asm volatile("s_waitcnt vmcnt(" #n ")" ::: "memory")
#define PG8_WAIT_L(n) asm volatile("s_waitcnt lgkmcnt(" #n ")" ::: "memory")
#define PG8_BAR __builtin_amdgcn_s_barrier()
#define PG8_SCHED __builtin_amdgcn_sched_barrier(0)
  Unit cur, nxt; int ui = 0;
  if (!S.next(0, cur)) return;
  f32x4 acc[2][2][4][2];
#pragma unroll
  for (int a = 0; a < 2; ++a)
#pragma unroll
    for (int b = 0; b < 2; ++b)
#pragma unroll
      for (int m = 0; m < 4; ++m)
#pragma unroll
        for (int n = 0; n < 2; ++n) acc[a][b][m][n] = (f32x4){0.f, 0.f, 0.f, 0.f};
  bf16x8 At[4][2], B0[2][2], B1[2][2];
  const char* cA = cur.a; const char* cB = cur.b;
  PG8_STAGE(PG8_SB(0, 0), cB, voffB); PG8_STAGE(PG8_SA(0, 0), cA, voffA); PG8_STAGE(PG8_SB(0, 1), cB + hstep, voffB); PG8_STAGE(PG8_SA(0, 1), cA + hstep, voffA);
  if (wr == 1) PG8_BAR;
  PG8_WAIT_V(4); PG8_BAR;
  PG8_STAGE(PG8_SB(1, 0), cB + kstep, voffB); PG8_STAGE(PG8_SA(1, 0), cA + kstep, voffA); PG8_STAGE(PG8_SB(1, 1), cB + hstep + kstep, voffB);
  PG8_WAIT_V(6); PG8_BAR;
  for (;;) {
    const bool has_next = S.next(ui + 1, nxt);
    const char* nA = has_next ? nxt.a : cA; const char* nB = has_next ? nxt.b : cB;
    for (int t = 0; t < nt; t += 2) {
      const bool last = (t == nt - 2);
      const char* a1 = cA + (size_t)(t + 1) * kstep;
      const char* a2 = last ? nA : cA + (size_t)(t + 2) * kstep; const char* b2 = last ? nB : cB + (size_t)(t + 2) * kstep;
      const char* a3 = a2 + kstep; const char* b3 = b2 + kstep;
      PG8_LDB(B0, 0, 0); PG8_SCHED; PG8_LDA(At, 0, 0); PG8_STAGE(PG8_SA(1, 1), a1 + hstep, voffA);
      PG8_WAIT_L(8); PG8_BAR; PG8_WAIT_L(0); PG8_MMA(0, 0, At, B0); PG8_BAR; PG8_SCHED;
      PG8_LDB(B1, 0, 1); PG8_STAGE(PG8_SB(0, 0), b2, voffB);
      PG8_BAR; PG8_WAIT_L(0); PG8_MMA(0, 1, At, B1); PG8_BAR;
      PG8_LDA(At, 0, 1); PG8_STAGE(PG8_SA(0, 0), a2, voffA);
      PG8_BAR; PG8_WAIT_L(0); PG8_MMA(1, 0, At, B0); PG8_BAR; PG8_SCHED;
      PG8_STAGE(PG8_SB(0, 1), b2 + hstep, voffB);
      PG8_WAIT_V(6); PG8_BAR; PG8_MMA(1, 1, At, B1); PG8_BAR;
      PG8_LDB(B0, 1, 0); PG8_SCHED; PG8_LDA(At, 1, 0); PG8_STAGE(PG8_SA(0, 1), a2 + hstep, voffA);
      PG8_WAIT_L(8); PG8_BAR; PG8_WAIT_L(0); PG8_MMA(0, 0, At, B0); PG8_BAR; PG8_SCHED;
      PG8_LDB(B1, 1, 1); PG8_STAGE(PG8_SB(1, 0), b3, voffB);
      PG8_BAR; PG8_WAIT_L(0); PG8_MMA(0, 1, At, B1); PG8_BAR;
      PG8_LDA(At, 1, 1); PG8_STAGE(PG8_SA(1, 0), a3, voffA);
      PG8_BAR; PG8_WAIT_L(0); PG8_MMA(1, 0, At, B0); PG8_BAR; PG8_SCHED;
      PG8_STAGE(PG8_SB(1, 1), b3 + hstep, voffB);
      PG8_WAIT_V(6); PG8_BAR; PG8_MMA(1, 1, At, B1); PG8_BAR;
    }
    E(acc, cur, wr, wc, fr, fq);
    E.done(cur, ui, has_next, lane);
    if (!has_next) break;
#pragma unroll
    for (int a = 0; a < 2; ++a)
#pragma unroll
      for (int b = 0; b < 2; ++b)
#pragma unroll
        for (int m = 0; m < 4; ++m)
#pragma unroll
          for (int n = 0; n < 2; ++n) acc[a][b][m][n] = (f32x4){0.f, 0.f, 0.f, 0.f};
    cur = nxt; cA = nA; cB = nB; ++ui;
  }
  PG8_WAIT_V(0);
  if (wr == 0) PG8_BAR;
  PG8_BAR;
#undef PG8_SA
#undef PG8_SB
#undef PG8_STAGE
#undef PG8_LDA
#undef PG8_LDB
#undef PG8_MMA
#undef PG8_WAIT_V
#undef PG8_WAIT_L
#undef PG8_BAR
#undef PG8_SCHED
}

constexpr int TILEB = 35840;
constexpr int LUT_OFF = 2 * TILEB;
constexpr int MISC_OFF = LUT_OFF + 8192;

template <int NKS>
DI void flash_core(unsigned char* smem, const u16* qptr, const u16* kbase, int kld, const u16* vtbase, int vld,
                   int ntb, int ntw, int nvalid, int ks0, const float* lut, int qpos, bool active,
                   f32x16 (&O)[4], float& m_out, float& l_out) {
  int tid = threadIdx.x; asm volatile("" : "+v"(tid));
  const int lane = tid & 63;
  const int r = lane & 31, hh = lane >> 5;
  bf16x8 qf[NKS];
#pragma unroll
  for (int s = 0; s < NKS; ++s) qf[s] = *reinterpret_cast<const bf16x8*>(qptr + s * 16);
#pragma unroll
  for (int t = 0; t < 4; ++t)
#pragma unroll
    for (int e = 0; e < 16; ++e) O[t][e] = 0.f;
  float m = -1e30f, l = 0.f;

  const int krow = tid >> 4, kch = tid & 15;
  const u16* kg = kbase + (size_t)krow * kld + kch * 8;
  const int vrow = tid >> 3, vch = tid & 7;
  const u16* vg = vtbase + (size_t)vrow * vld + vch * 8;
  const int ksoff = krow * 272 + kch * 16;
  const int vsoff = 17408 + vrow * 144 + vch * 16;
  u32x4 kr0, kr1, vr0, vr1;
  kr0 = *reinterpret_cast<const u32x4*>(kg);
  kr1 = *reinterpret_cast<const u32x4*>(kg + (size_t)32 * kld);
  vr0 = *reinterpret_cast<const u32x4*>(vg);
  vr1 = *reinterpret_cast<const u32x4*>(vg + (size_t)64 * vld);
  *reinterpret_cast<u32x4*>(smem + ksoff) = kr0;
  *reinterpret_cast<u32x4*>(smem + ksoff + 32 * 272) = kr1;
  *reinterpret_cast<u32x4*>(smem + vsoff) = vr0;
  *reinterpret_cast<u32x4*>(smem + vsoff + 64 * 144) = vr1;
  __syncthreads();

  for (int t = 0; t < ntb; ++t) {
    const unsigned char* cur = smem + (t & 1) * TILEB;
    unsigned char* nxt = smem + ((t + 1) & 1) * TILEB;
    const bool more = (t + 1 < ntb);
    if (more) {
      kr0 = *reinterpret_cast<const u32x4*>(kg + (size_t)(64 * (t + 1)) * kld);
      kr1 = *reinterpret_cast<const u32x4*>(kg + (size_t)(64 * (t + 1) + 32) * kld);
      vr0 = *reinterpret_cast<const u32x4*>(vg + 64 * (t + 1));
      vr1 = *reinterpret_cast<const u32x4*>(vg + (size_t)64 * vld + 64 * (t + 1));
    }
    if (active && t < ntw) {
      f32x16 S[2];
#pragma unroll
      for (int kb = 0; kb < 2; ++kb)
#pragma unroll
        for (int e = 0; e < 16; ++e) S[kb][e] = 0.f;
      const unsigned char* kb0 = cur + r * 272 + (ks0 * 16 + hh * 8) * 2;
#pragma unroll
      for (int s = 0; s < NKS; ++s)
#pragma unroll
        for (int kb = 0; kb < 2; ++kb) {
          const bf16x8 kf = *reinterpret_cast<const bf16x8*>(kb0 + kb * 32 * 272 + s * 32);
          S[kb] = MFMA(kf, qf[s], S[kb]);
        }
      if (lut != nullptr && t >= ntw - 3) {
        const int base = t * 64 - qpos + 191;
#pragma unroll
        for (int kb = 0; kb < 2; ++kb)
#pragma unroll
          for (int i = 0; i < 16; ++i) S[kb][i] += lut[base + kb * 32 + crow(i, hh)];
      }
      if (t == ntw - 1 && nvalid < 64) {
#pragma unroll
        for (int kb = 0; kb < 2; ++kb)
#pragma unroll
          for (int i = 0; i < 16; ++i)
            if (kb * 32 + crow(i, hh) >= nvalid) S[kb][i] = -1e30f;
      }
      float mx = m;
#pragma unroll
      for (int kb = 0; kb < 2; ++kb)
#pragma unroll
        for (int i = 0; i < 16; ++i) mx = fmaxf(mx, S[kb][i]);
      mx = fmaxf(mx, __shfl_xor(mx, 32));
      const float alpha = __builtin_amdgcn_exp2f(m - mx);
      m = mx;
      float ps = 0.f;
#pragma unroll
      for (int kb = 0; kb < 2; ++kb)
#pragma unroll
        for (int i = 0; i < 16; ++i) {
          const float pv = __builtin_amdgcn_exp2f(S[kb][i] - mx);
          S[kb][i] = pv;
          ps += pv;
        }
      l = l * alpha + ps;
#pragma unroll
      for (int tt = 0; tt < 4; ++tt)
#pragma unroll
        for (int e = 0; e < 16; ++e) O[tt][e] *= alpha;
      const unsigned char* vb0 = cur + 17408 + r * 144 + hh * 16;
#pragma unroll
      for (int kb = 0; kb < 2; ++kb)
#pragma unroll
        for (int s2 = 0; s2 < 2; ++s2) {
          u32x4 pk;
          pk.x = pack2(S[kb][8 * s2 + 0], S[kb][8 * s2 + 1]);
          pk.y = pack2(S[kb][8 * s2 + 2], S[kb][8 * s2 + 3]);
          pk.z = pack2(S[kb][8 * s2 + 4], S[kb][8 * s2 + 5]);
          pk.w = pack2(S[kb][8 * s2 + 6], S[kb][8 * s2 + 7]);
          const bf16x8 pf = __builtin_bit_cast(bf16x8, pk);
#pragma unroll
          for (int tt = 0; tt < 4; ++tt) {
            const bf16x8 vf = *reinterpret_cast<const bf16x8*>(vb0 + tt * 32 * 144 + (kb * 32 + s2 * 16) * 2);
            O[tt] = MFMA(vf, pf, O[tt]);
          }
        }
    }
    if (more) {
      *reinterpret_cast<u32x4*>(nxt + ksoff) = kr0;
      *reinterpret_cast<u32x4*>(nxt + ksoff + 32 * 272) = kr1;
      *reinterpret_cast<u32x4*>(nxt + vsoff) = vr0;
      *reinterpret_cast<u32x4*>(nxt + vsoff + 64 * 144) = vr1;
    }
    __syncthreads();
  }
  m_out = m;
  l_out = l + __shfl_xor(l, 32);
}

constexpr int D_SLOT = 32768;
constexpr int D_LUT_OFF = 4 * D_SLOT;
constexpr int D_MISC_OFF = D_LUT_OFF + 8192;

DI void diff_core(unsigned char* smem, const u16* qptr, const u16* kbase, const u16* vtbase, int vld,
                  int ntb, int ntw, int nvalid, int ks0, const float* lut, int qpos, bool active, bool grpB,
                  f32x16 (&O)[4], float& l_out) {
  int tid = threadIdx.x; asm volatile("" : "+v"(tid));
  const int lane = tid & 63, w = __builtin_amdgcn_readfirstlane(tid >> 6);
  const int r = lane & 31, hh = lane >> 5;
  constexpr int kld = 1024;
  LAS unsigned char* lds = (LAS unsigned char*)smem;
  bf16x8 qf[4];
#pragma unroll
  for (int s = 0; s < 4; ++s) qf[s] = *reinterpret_cast<const bf16x8*>(qptr + s * 16);
#pragma unroll
  for (int t = 0; t < 4; ++t)
#pragma unroll
    for (int e = 0; e < 16; ++e) O[t][e] = 0.f;
  float m = 0.f, l = 0.f;
  f32x16 S[2];
  u32x4 P[4];
#pragma unroll
  for (int i = 0; i < 4; ++i) P[i] = (u32x4){0u, 0u, 0u, 0u};
#pragma unroll
  for (int kb = 0; kb < 2; ++kb)
#pragma unroll
    for (int e = 0; e < 16; ++e) S[kb][e] = 0.f;

  unsigned ksrc[2], vsrc[2];
#pragma unroll
  for (int i = 0; i < 2; ++i) {
    const int ci = (i * 8 + w) * 64 + lane;
    const int krow = ci >> 4, kc = (ci & 15) ^ (krow & 15);
    ksrc[i] = (unsigned)(krow * kld + kc * 8) * 2u;
    const int vrow = ci >> 3, vc = (ci & 7) ^ ((vrow >> 1) & 7);
    vsrc[i] = (unsigned)(vrow * vld + vc * 8) * 2u;
  }
  auto dma_piece = [&](int t, int slot, int piece) {
    LAS unsigned char* b = lds + slot * D_SLOT + w * 1024;
    const char* kt = (const char*)kbase + (size_t)(64 * t) * kld * 2;
    const char* vt = (const char*)vtbase + (size_t)(64 * t) * 2;
    if (piece == 0) __builtin_amdgcn_global_load_lds((const unsigned*)(kt + ksrc[0]), (LAS unsigned*)(b), 16, 0, 0);
    else if (piece == 1) __builtin_amdgcn_global_load_lds((const unsigned*)(kt + ksrc[1]), (LAS unsigned*)(b + 8192), 16, 0, 0);
    else if (piece == 2) __builtin_amdgcn_global_load_lds((const unsigned*)(vt + vsrc[0]), (LAS unsigned*)(b + 16384), 16, 0, 0);
    else __builtin_amdgcn_global_load_lds((const unsigned*)(vt + vsrc[1]), (LAS unsigned*)(b + 24576), 16, 0, 0);
  };
  auto dma = [&](int t, int slot) { dma_piece(t, slot, 0); dma_piece(t, slot, 1); dma_piece(t, slot, 2); dma_piece(t, slot, 3); };
  int koff[4], voff[4];
#pragma unroll
  for (int s = 0; s < 4; ++s) {
    koff[s] = r * 256 + (((2 * (ks0 + s) + hh) ^ (r & 15)) << 4);
    voff[s] = 16384 + r * 128 + (((2 * s + hh) ^ ((r >> 1) & 7)) << 4);
  }
  auto qk = [&](int slot) {
    __builtin_amdgcn_s_setprio(1);
    const float ini = -m;
#pragma unroll
    for (int kb = 0; kb < 2; ++kb)
#pragma unroll
      for (int e = 0; e < 16; ++e) S[kb][e] = ini;
    const LAS unsigned char* b = lds + slot * D_SLOT;
    bf16x8 kf[4][2];
#pragma unroll
    for (int s = 0; s < 4; ++s)
#pragma unroll
      for (int kb = 0; kb < 2; ++kb) kf[s][kb] = *reinterpret_cast<const LAS bf16x8*>(b + koff[s] + kb * 32 * 256);
#pragma unroll
    for (int s = 0; s < 4; ++s)
#pragma unroll
      for (int kb = 0; kb < 2; ++kb) S[kb] = MFMA(kf[s][kb], qf[s], S[kb]);
    __builtin_amdgcn_sched_group_barrier(0x100, 8, 0);
    __builtin_amdgcn_sched_group_barrier(0x008, 8, 0);
    __builtin_amdgcn_s_setprio(0);
  };
  auto pv = [&](int slot) {
    __builtin_amdgcn_s_setprio(1);
    const LAS unsigned char* b = lds + slot * D_SLOT;
    bf16x8 va[4], vb[4];
#pragma unroll
    for (int tt = 0; tt < 4; ++tt) va[tt] = *reinterpret_cast<const LAS bf16x8*>(b + voff[0] + tt * 32 * 128);
#pragma unroll
    for (int tt = 0; tt < 4; ++tt) vb[tt] = *reinterpret_cast<const LAS bf16x8*>(b + voff[1] + tt * 32 * 128);
    {
      const bf16x8 pf = __builtin_bit_cast(bf16x8, P[0]);
#pragma unroll
      for (int tt = 0; tt < 4; ++tt) O[tt] = MFMA(va[tt], pf, O[tt]);
    }
#pragma unroll
    for (int tt = 0; tt < 4; ++tt) va[tt] = *reinterpret_cast<const LAS bf16x8*>(b + voff[2] + tt * 32 * 128);
    {
      const bf16x8 pf = __builtin_bit_cast(bf16x8, P[1]);
#pragma unroll
      for (int tt = 0; tt < 4; ++tt) O[tt] = MFMA(vb[tt], pf, O[tt]);
    }
#pragma unroll
    for (int tt = 0; tt < 4; ++tt) vb[tt] = *reinterpret_cast<const LAS bf16x8*>(b + voff[3] + tt * 32 * 128);
    {
      const bf16x8 pf = __builtin_bit_cast(bf16x8, P[2]);
#pragma unroll
      for (int tt = 0; tt < 4; ++tt) O[tt] = MFMA(va[tt], pf, O[tt]);
    }
    {
      const bf16x8 pf = __builtin_bit_cast(bf16x8, P[3]);
#pragma unroll
      for (int tt = 0; tt < 4; ++tt) O[tt] = MFMA(vb[tt], pf, O[tt]);
    }
    __builtin_amdgcn_sched_group_barrier(0x100, 8, 0);
    __builtin_amdgcn_sched_group_barrier(0x008, 4, 0);
    __builtin_amdgcn_sched_group_barrier(0x100, 4, 0);
    __builtin_amdgcn_sched_group_barrier(0x008, 4, 0);
    __builtin_amdgcn_sched_group_barrier(0x100, 4, 0);
    __builtin_amdgcn_sched_group_barrier(0x008, 8, 0);
    __builtin_amdgcn_s_setprio(0);
  };
  auto softmax = [&](int t) {
    if (lut != nullptr && t >= ntw - 3) {
      const int base = t * 64 - qpos + 191;
#pragma unroll
      for (int kb = 0; kb < 2; ++kb)
#pragma unroll
        for (int i = 0; i < 16; ++i) S[kb][i] += lut[base + kb * 32 + crow(i, hh)];
    }
    if (t == ntw - 1 && nvalid < 64) {
#pragma unroll
      for (int kb = 0; kb < 2; ++kb)
#pragma unroll
        for (int i = 0; i < 16; ++i)
          if (kb * 32 + crow(i, hh) >= nvalid) S[kb][i] = -1e30f;
    }
    float mx = S[0][0];
#pragma unroll
    for (int kb = 0; kb < 2; ++kb)
#pragma unroll
      for (int i = 0; i < 16; ++i) mx = fmaxf(mx, S[kb][i]);
    {
      const unsigned um = __float_as_uint(mx);
      const auto sw = __builtin_amdgcn_permlane32_swap(um, um, false, false);
      mx = fmaxf(__uint_as_float(sw[0]), __uint_as_float(sw[1]));
    }
    if (t == 0) {
      m = mx;
#pragma unroll
      for (int kb = 0; kb < 2; ++kb)
#pragma unroll
        for (int i = 0; i < 16; ++i) S[kb][i] -= mx;
    } else if (__any(mx > 8.f)) {
      const float d = fmaxf(mx, 0.f);
      const float alpha = __builtin_amdgcn_exp2f(-d);
      m += d;
      l *= alpha;
#pragma unroll
      for (int tt = 0; tt < 4; ++tt)
#pragma unroll
        for (int e = 0; e < 16; ++e) O[tt][e] *= alpha;
#pragma unroll
      for (int kb = 0; kb < 2; ++kb)
#pragma unroll
        for (int i = 0; i < 16; ++i) S[kb][i] -= d;
    }
    float ps = 0.f;
#pragma unroll
    for (int kb = 0; kb < 2; ++kb)
#pragma unroll
      for (int i = 0; i < 16; ++i) {
        const float pe = __builtin_amdgcn_exp2f(S[kb][i]);
        S[kb][i] = pe;
        ps += pe;
      }
    l += ps;
#pragma unroll
    for (int kb = 0; kb < 2; ++kb)
#pragma unroll
      for (int s2 = 0; s2 < 2; ++s2) {
        u32x4 pk;
        pk.x = pack2(S[kb][8 * s2 + 0], S[kb][8 * s2 + 1]);
        pk.y = pack2(S[kb][8 * s2 + 2], S[kb][8 * s2 + 3]);
        pk.z = pack2(S[kb][8 * s2 + 4], S[kb][8 * s2 + 5]);
        pk.w = pack2(S[kb][8 * s2 + 6], S[kb][8 * s2 + 7]);
        P[kb * 2 + s2] = pk;
      }
  };
#define D_BAR do { asm volatile("" ::: "memory"); __builtin_amdgcn_s_barrier(); asm volatile("" ::: "memory"); } while (0)
  const int tlast = ntb - 1;
  asm volatile("s_waitcnt vmcnt(0)" :: "v"(qf[0]), "v"(qf[1]), "v"(qf[2]), "v"(qf[3]) : "memory");
  dma(0, 0); dma(1 < tlast ? 1 : tlast, 1);
  if (!grpB) { dma(2 < tlast ? 2 : tlast, 2); asm volatile("s_waitcnt vmcnt(8)" ::: "memory"); }
  else { asm volatile("s_waitcnt vmcnt(4)" ::: "memory"); }
  D_BAR;
  if (grpB && active) qk(0);
  if (!grpB) {
    for (int t = 0; t <= ntb; ++t) {
      const bool act_t = active && (t < ntw);
      if (active && t >= 1 && (t - 1) < ntw) pv((t + 3) & 3);
      __builtin_amdgcn_sched_barrier(0);
      if (act_t) qk(t & 3);
      asm volatile("s_waitcnt vmcnt(4)" ::: "memory");
      D_BAR;
      { const int tn = t + 3; dma(tn < tlast ? tn : tlast, tn & 3); }
      if (act_t) softmax(t);
    }
  } else {
    for (int t = 0; t <= ntb; ++t) {
      const bool act_t = active && (t < ntw);
      { const int tn = t + 2; dma(tn < tlast ? tn : tlast, tn & 3); }
      if (act_t) softmax(t);
      asm volatile("s_waitcnt vmcnt(4)" ::: "memory");
      D_BAR;
      if (act_t) pv(t & 3);
      __builtin_amdgcn_sched_barrier(0);
      if (active && (t + 1) < ntw) qk((t + 1) & 3);
    }
  }
  __builtin_amdgcn_s_setprio(0);
  asm volatile("s_waitcnt vmcnt(0)" ::: "memory");
  __syncthreads();
#undef D_BAR
  l_out = l + __shfl_xor(l, 32);
}

__device__ void diff_item(const Params& p, unsigned char* smem, bool sample, int b, int h, int qb, float lam) {
  int tid = threadIdx.x; asm volatile("" : "+v"(tid));
  const int lane = tid & 63, w = __builtin_amdgcn_readfirstlane(tid >> 6);
  const int r = lane & 31, hh = lane >> 5;
  const int g = w & 3, c = w >> 2;
  const float* lut = reinterpret_cast<const float*>(smem + D_LUT_OFF) + h * 256;
  int tok, qpos, ntb, ntw, nvalid;
  bool active, valid;
  const u16 *kbase, *vtbase;
  int vld;
  if (!sample) {
    const int s = qb * 128 + g * 32 + r;
    tok = b * SEQ + s;
    qpos = s - r;
    ntw = 2 * qb + (g >> 1) + 1;
    ntb = 2 * qb + 2;
    nvalid = 64;
    active = true; valid = true;
    kbase = p.Kall + (size_t)b * SEQ * 1024 + h * 128;
    vtbase = p.VTp + (size_t)(b * 1024 + h * 128) * SEQ;
    vld = SEQ;
  } else {
    tok = NPROMPT + b * 16 + (r < 16 ? r : 15);
    qpos = 1024;
    ntw = 17; ntb = 17; nvalid = 16;
    active = (g == 0); valid = (r < 16);
    kbase = p.Kall + ((size_t)NPROMPT + (size_t)b * SKV) * 1024 + h * 128;
    vtbase = p.VTs + (size_t)(b * 1024 + h * 128) * SKV;
    vld = SKV;
  }
  const u16* qptr = p.Qb + (size_t)tok * 1024 + h * 128 + c * 64 + hh * 8;
  f32x16 O[4];
  float l;
  diff_core(smem, qptr, kbase, vtbase, vld, ntb, ntw, nvalid, 4 * c, lut, qpos + r, active, c == 1, O, l);
  u32x2 gv[16];
  u16* zrow = p.Xb + (size_t)tok * 2048 + h * 128;
  if (c == 0 && active) {
    const u16* grow = p.Gb + (size_t)tok * 2048 + h * 128;
#pragma unroll
    for (int t = 0; t < 4; ++t)
#pragma unroll
      for (int gq = 0; gq < 4; ++gq) gv[t * 4 + gq] = *reinterpret_cast<const u32x2*>(grow + 32 * t + 8 * gq + 4 * hh);
  }
  float* ex = reinterpret_cast<float*>(smem) + g * 4096;
  if (c == 1 && active) {
    const float sc = lam / l;
#pragma unroll
    for (int t = 0; t < 4; ++t)
#pragma unroll
      for (int i = 0; i < 16; ++i) ex[(t * 16 + i) * 64 + lane] = O[t][i] * sc;
  }
  __syncthreads();
  if (c == 0 && active) {
    const float inv = 1.f / l;
    float ss = 0.f;
#pragma unroll
    for (int t = 0; t < 4; ++t)
#pragma unroll
      for (int i = 0; i < 16; ++i) {
        const float o = O[t][i] * inv - ex[(t * 16 + i) * 64 + lane];
        O[t][i] = o;
        ss += o * o;
      }
    ss += __shfl_xor(ss, 32);
    const float rinv = rsqrtf(ss * (1.f / 128.f) + EPSV);
    if (valid) {
#pragma unroll
      for (int t = 0; t < 4; ++t)
#pragma unroll
        for (int gq = 0; gq < 4; ++gq) {
          const int e = 32 * t + 8 * gq + 4 * hh;
          const u32x2 gg = gv[t * 4 + gq];
          const float o0 = O[t][4 * gq + 0] * rinv * __uint_as_float(gg.x << 16);
          const float o1 = O[t][4 * gq + 1] * rinv * __uint_as_float(gg.x & 0xffff0000u);
          const float o2 = O[t][4 * gq + 2] * rinv * __uint_as_float(gg.y << 16);
          const float o3 = O[t][4 * gq + 3] * rinv * __uint_as_float(gg.y & 0xffff0000u);
          u32x2 zo;
          zo.x = pack2(o0, o1);
          zo.y = pack2(o2, o3);
          *reinterpret_cast<u32x2*>(zrow + e) = zo;
        }
    }
  }
  __syncthreads();
}

__device__ void mem_item(const Params& p, unsigned char* smem, bool sample, int b, int h, int qblk) {
  int tid = threadIdx.x; asm volatile("" : "+v"(tid));
  const int lane = tid & 63, w = __builtin_amdgcn_readfirstlane(tid >> 6);
  const int r = lane & 31, hh = lane >> 5;
  int tok, mb;
  bool active, valid;
  if (!sample) {
    tok = qblk * 256 + w * 32 + r;
    mb = tok >> 14;
    active = true; valid = true;
  } else {
    tok = NPROMPT + b * 16 + (r < 16 ? r : 15);
    mb = 2 + b;
    active = (w == 0); valid = (r < 16);
  }
  const u16* qptr = p.MQb + (size_t)tok * 512 + h * 128 + hh * 8;
  const u16* kbase = p.MKall + (size_t)mb * 256 * 512 + h * 128;
  const u16* vtbase = p.MVTall + (size_t)(mb * 4 + h) * 128 * 256;
  f32x16 O[4];
  float m, l;
  flash_core<8>(smem, qptr, kbase, 512, vtbase, 256, 4, 4, 64, 0, nullptr, 0, active, O, m, l);
  if (active && valid) {
    const float inv = 1.f / l;
    const u16* grow = p.Gb + (size_t)tok * 2048 + 1536 + h * 128;
    u16* zrow = p.Xb + (size_t)tok * 2048 + 1536 + h * 128;
    u32x2 gv[16];
#pragma unroll
    for (int t = 0; t < 4; ++t)
#pragma unroll
      for (int gq = 0; gq < 4; ++gq) gv[t * 4 + gq] = *reinterpret_cast<const u32x2*>(grow + 32 * t + 8 * gq + 4 * hh);
#pragma unroll
    for (int t = 0; t < 4; ++t)
#pragma unroll
      for (int gq = 0; gq < 4; ++gq) {
        const int e = 32 * t + 8 * gq + 4 * hh;
        const u32x2 gg = gv[t * 4 + gq];
        const float o0 = O[t][4 * gq + 0] * inv * __uint_as_float(gg.x << 16);
        const float o1 = O[t][4 * gq + 1] * inv * __uint_as_float(gg.x & 0xffff0000u);
        const float o2 = O[t][4 * gq + 2] * inv * __uint_as_float(gg.y << 16);
        const float o3 = O[t][4 * gq + 3] * inv * __uint_as_float(gg.y & 0xffff0000u);
        u32x2 zo;
        zo.x = pack2(o0, o1);
        zo.y = pack2(o2, o3);
        *reinterpret_cast<u32x2*>(zrow + e) = zo;
      }
  }
}

DI void unpack8(const u32x4 v, float (&f)[8]) {
  f[0] = __uint_as_float(v.x << 16); f[1] = __uint_as_float(v.x & 0xffff0000u);
  f[2] = __uint_as_float(v.y << 16); f[3] = __uint_as_float(v.y & 0xffff0000u);
  f[4] = __uint_as_float(v.z << 16); f[5] = __uint_as_float(v.z & 0xffff0000u);
  f[6] = __uint_as_float(v.w << 16); f[7] = __uint_as_float(v.w & 0xffff0000u);
}
__device__ void conv_item(const Params& p, int it) {
  const int cg = threadIdx.x & 63, tl = threadIdx.x >> 6;
  const int c0 = cg * 8;
  float w0[8], w1[8], w2[8];
#pragma unroll
  for (int j = 0; j < 8; ++j) { w0[j] = p.conv_w[c0 + j]; w1[j] = p.conv_w[512 + c0 + j]; w2[j] = p.conv_w[1024 + c0 + j]; }
#pragma unroll 2
  for (int k = 0; k < 8; ++k) {
    const int tok = it * 64 + k * 8 + tl;
    const size_t o = (size_t)tok * 512 + c0;
    float u0[8], u1[8], u2[8], bg[8], gt[8], a[8], b[8];
    unpack8(*reinterpret_cast<const u32x4*>(p.Cb + o), a);
    unpack8(*reinterpret_cast<const u32x4*>(p.Hb + o), b);
#pragma unroll
    for (int j = 0; j < 8; ++j) u0[j] = a[j] * b[j];
    const bool prompt = tok < NPROMPT;
    const int s = prompt ? (tok & (SEQ - 1)) : ((tok - NPROMPT) & 15);
    const int sb = prompt ? 0 : ((tok - NPROMPT) >> 4);
    if (s >= 1) {
      unpack8(*reinterpret_cast<const u32x4*>(p.Cb + o - 512), a);
      unpack8(*reinterpret_cast<const u32x4*>(p.Hb + o - 512), b);
#pragma unroll
      for (int j = 0; j < 8; ++j) u1[j] = a[j] * b[j];
    } else {
#pragma unroll
      for (int j = 0; j < 8; ++j) u1[j] = prompt ? 0.f : p.cache_conv[(size_t)(sb * 2 + 1) * 512 + c0 + j];
    }
    if (s >= 2) {
      unpack8(*reinterpret_cast<const u32x4*>(p.Cb + o - 1024), a);
      unpack8(*reinterpret_cast<const u32x4*>(p.Hb + o - 1024), b);
#pragma unroll
      for (int j = 0; j < 8; ++j) u2[j] = a[j] * b[j];
    } else {
#pragma unroll
      for (int j = 0; j < 8; ++j) u2[j] = prompt ? 0.f : p.cache_conv[(size_t)(sb * 2 + s) * 512 + c0 + j];
    }
    unpack8(*reinterpret_cast<const u32x4*>(p.Bb + o), bg);
    unpack8(*reinterpret_cast<const u32x4*>(p.Gb + (size_t)tok * 2048 + 1024 + c0), gt);
    float z[8];
#pragma unroll
    for (int j = 0; j < 8; ++j) z[j] = bg[j] * (w0[j] * u2[j] + w1[j] * u1[j] + w2[j] * u0[j]) * gt[j];
    u32x4 zo;
    zo.x = pack2(z[0], z[1]); zo.y = pack2(z[2], z[3]); zo.z = pack2(z[4], z[5]); zo.w = pack2(z[6], z[7]);
    *reinterpret_cast<u32x4*>(p.Xb + (size_t)tok * 2048 + 1024 + c0) = zo;
    float* od = nullptr;
    if (prompt) { if (s >= SEQ - 2) od = p.out + O_CP + (size_t)((tok >> 14) * 2 + (s - (SEQ - 2))) * 512 + c0; }
    else { if (s >= 14) od = p.out + O_CS + (size_t)(sb * 2 + (s - 14)) * 512 + c0; }
    if (od != nullptr) {
#pragma unroll
      for (int j = 0; j < 8; ++j) od[j] = u0[j];
    }
  }
}

DI int t5_bucket(int rel) {
  const int n = rel < 0 ? -rel : rel;
  int v;
  if (n < 8) v = n;
  else {
    const int lg = 31 - __clz(n * n);
    v = 2 + lg;
    if (v > 15) v = 15;
  }
  return (rel > 0 ? 16 : 0) + v;
}

__device__ void phaseB(const Params& p, unsigned char* smem, int pass, int item_lo, int item_hi) {
  const int tid = threadIdx.x;
  float* lut = reinterpret_cast<float*>(smem + D_LUT_OFF);
  float* misc = reinterpret_cast<float*>(smem + D_MISC_OFF);
  int* s_item = reinterpret_cast<int*>(smem + D_MISC_OFF + 64);
  for (int i = tid; i < 8 * 256; i += NTHR) {
    const int h = i >> 8, idx = i & 255;
    const int rel = idx - 191;
    lut[i] = (p.rel_table[t5_bucket(rel) * 8 + h] - p.rel_table[15 * 8 + h]) * LOG2E;
  }
  if (tid == 0) {
    float a = 0.f, bsum = 0.f;
    for (int i = 0; i < 64; ++i) { a += p.lq1[i] * p.lk1[i]; bsum += p.lq2[i] * p.lk2[i]; }
    misc[0] = __expf(a) - __expf(bsum) + 0.2f;
  }
  __syncthreads();
  const float lam = misc[0];
  constexpr int N_DP = 2048, N_DS = 256, N_MP = 512, N_MS = 128, N_CV = 520;
  constexpr int N_ALL = N_DP + N_DS + N_MP + N_MS + N_CV;
  int* ctr = p.counter + pass * 16;
  const int xcd = blockIdx.x & 7;
  if (item_lo == 0) {
#pragma unroll 1
    for (int qi = 0; qi < 8; ++qi) {
      const int queue = (xcd + qi) & 7;
      for (;;) {
        if (tid == 0) *s_item = atomicAdd(ctr + 1 + queue, 1);
        __syncthreads();
        const int j = *s_item;
        __syncthreads();
        if (j >= 256) break;
        const int bh = 2 * queue + (j & 1), qb = 127 - (j >> 1);
        diff_item(p, smem, false, bh >> 3, bh & 7, qb, lam);
      }
    }
  }
  if (gridDim.x == 256) {
    if (tid < 64) {
      while (__hip_atomic_load(p.lnready + 9, __ATOMIC_RELAXED, __HIP_MEMORY_SCOPE_AGENT) < 64) __builtin_amdgcn_s_sleep(8);
      __builtin_amdgcn_fence(__ATOMIC_ACQUIRE, "agent");
      asm volatile("s_waitcnt vmcnt(0)" ::: "memory");
    }
    __syncthreads();
  }
  for (;;) {
    if (tid == 0) *s_item = atomicAdd(ctr, 1);
    __syncthreads();
    int it = *s_item + (item_lo > N_DP ? item_lo : N_DP);
    __syncthreads();
    if (it >= item_hi || it >= N_ALL) break;
    it -= N_DP;
    if (it < N_DS) { diff_item(p, smem, true, it >> 3, it & 7, 0, lam); continue; }
    it -= N_DS;
    if (it < N_MP) { mem_item(p, smem, false, 0, it & 3, it >> 2); continue; }
    it -= N_MP;
    if (it < N_MS) { mem_item(p, smem, true, it >> 2, it & 3, 0); continue; }
    it -= N_MS;
    conv_item(p, it);
  }
}

DI void ln_finish(const Params& p, float* __restrict__ pr, const float4 (&v)[8], int lane) {
  float s = 0.f;
#pragma unroll
  for (int i = 0; i < 8; ++i) s += v[i].x + v[i].y + v[i].z + v[i].w;
#pragma unroll
  for (int o = 32; o >= 1; o >>= 1) s += __shfl_xor(s, o);
  const float mu = s * (1.f / 2048.f);
  float q = 0.f;
#pragma unroll
  for (int i = 0; i < 8; ++i) {
    const float a = v[i].x - mu, b = v[i].y - mu, c = v[i].z - mu, d = v[i].w - mu;
    q += a * a + b * b + c * c + d * d;
  }
#pragma unroll
  for (int o = 32; o >= 1; o >>= 1) q += __shfl_xor(q, o);
  const float rstd = rsqrtf(q * (1.f / 2048.f) + EPSV);
#pragma unroll
  for (int i = 0; i < 8; ++i) {
    const int c0 = (i * 64 + lane) * 4;
    const float4 g = *reinterpret_cast<const float4*>(p.ln_g + c0);
    const float4 bb = *reinterpret_cast<const float4*>(p.ln_b + c0);
    float4 o;
    o.x = (v[i].x - mu) * rstd * g.x + bb.x;
    o.y = (v[i].y - mu) * rstd * g.y + bb.y;
    o.z = (v[i].z - mu) * rstd * g.z + bb.z;
    o.w = (v[i].w - mu) * rstd * g.w + bb.w;
    *reinterpret_cast<float4*>(pr + c0) = o;
  }
}
__device__ void phaseD(const Params& p) {
  int tidd = threadIdx.x; asm volatile("" : "+v"(tidd));
  const int lane = tidd & 63, w = tidd >> 6;
  const int stride = gridDim.x * 8;
  int row = blockIdx.x * 8 + w;
  for (; row + stride < NTOK; row += 2 * stride) {
    float* pa = p.out + O_Y + (size_t)row * 2048;
    float* pb = p.out + O_Y + (size_t)(row + stride) * 2048;
    float4 va[8], vb[8];
#pragma unroll
    for (int i = 0; i < 8; ++i) va[i] = *reinterpret_cast<const float4*>(pa + (i * 64 + lane) * 4);
#pragma unroll
    for (int i = 0; i < 8; ++i) vb[i] = *reinterpret_cast<const float4*>(pb + (i * 64 + lane) * 4);
    ln_finish(p, pa, va, lane);
    ln_finish(p, pb, vb, lane);
  }
  if (row < NTOK) {
    float* pa = p.out + O_Y + (size_t)row * 2048;
    float4 va[8];
#pragma unroll
    for (int i = 0; i < 8; ++i) va[i] = *reinterpret_cast<const float4*>(pa + (i * 64 + lane) * 4);
    ln_finish(p, pa, va, lane);
  }
}

__device__ void phaseD_handoff(const Params& p, unsigned char* smem) {
  int tidd = threadIdx.x; asm volatile("" : "+v"(tidd));
  const int lane = tidd & 63, w = __builtin_amdgcn_readfirstlane(tidd >> 6);
  int* s_item = reinterpret_cast<int*>(smem);
  for (;;) {
    if (tidd == 0) *s_item = atomicAdd(p.lnready + 2, 1);
    __syncthreads();
    const int it = *s_item;
    __syncthreads();
    if (it >= 130 * 8) break;
    const int panel = it >> 3, chunk = it & 7;
    if (w == 0) {
      const int* flag = p.lnready + (panel < 128 ? 0 : 1);
      const int need = panel < 128 ? 2048 : 16;
      while (__hip_atomic_load(flag, __ATOMIC_RELAXED, __HIP_MEMORY_SCOPE_AGENT) < need) __builtin_amdgcn_s_sleep(8);
      __builtin_amdgcn_fence(__ATOMIC_ACQUIRE, "agent");
      asm volatile("s_waitcnt vmcnt(0)" ::: "memory");
    }
    __syncthreads();
    const int row0 = panel * 256 + chunk * 32 + w * 4;
#pragma unroll 1
    for (int k = 0; k < 2; ++k) {
      float* pa = p.out + O_Y + (size_t)(row0 + k) * 2048;
      float* pb = p.out + O_Y + (size_t)(row0 + 2 + k) * 2048;
      float4 va[8], vb[8];
#pragma unroll
      for (int i = 0; i < 8; ++i) va[i] = *reinterpret_cast<const float4*>(pa + (i * 64 + lane) * 4);
#pragma unroll
      for (int i = 0; i < 8; ++i) vb[i] = *reinterpret_cast<const float4*>(pb + (i * 64 + lane) * 4);
      ln_finish(p, pa, va, lane);
      ln_finish(p, pb, vb, lane);
    }
  }
}

DI void gbar(int* word, int nblocks) {
  int tg = threadIdx.x; asm volatile("" : "+v"(tg));
  asm volatile("s_waitcnt vmcnt(0)" ::: "memory");
  __syncthreads();
  if (tg == 0) {
    __builtin_amdgcn_fence(__ATOMIC_RELEASE, "agent");
    __hip_atomic_fetch_add(word, 1, __ATOMIC_RELAXED, __HIP_MEMORY_SCOPE_AGENT);
  }
  if (tg < 64) {
    while (__hip_atomic_load(word, __ATOMIC_RELAXED, __HIP_MEMORY_SCOPE_AGENT) < nblocks) __builtin_amdgcn_s_sleep(4);
    __builtin_amdgcn_fence(__ATOMIC_ACQUIRE, "agent");
    asm volatile("s_waitcnt vmcnt(0)" ::: "memory");
  }
  __syncthreads();
}

__global__ void __launch_bounds__(NTHR) fwd_megakernel(Params p) {
  extern __shared__ __attribute__((aligned(16))) unsigned char smem[];
  cg::grid_group grid = cg::this_grid();
  if (gridDim.x == 0x7fffffffu) grid.sync();

  if (p.mode != 0) return;
  phase0(p, smem);
  gbar(p.gbarw + 32, (int)gridDim.x);
#if STOP_AFTER == 0
  return;
#endif

  {
    SchedIn S; S.p = &p; S.G = (int)gridDim.x; S.c = (int)blockIdx.x;
    EpiAll E; E.p = &p; E.handoff = (gridDim.x == 256);
    gemm_phase<EpiAll, SchedIn>((LAS unsigned char*)smem, S, E);
  }
  const bool ho = (gridDim.x == 256);
  if (ho) {
    __syncthreads();
    if (threadIdx.x == 0) {
      __builtin_amdgcn_fence(__ATOMIC_RELEASE, "agent");
      if (blockIdx.x < 64) __hip_atomic_fetch_add(p.lnready + 9, 1, __ATOMIC_RELAXED, __HIP_MEMORY_SCOPE_AGENT);
      else __hip_atomic_fetch_add(p.lnready + 8, 8, __ATOMIC_RELAXED, __HIP_MEMORY_SCOPE_AGENT);
    }
    if (threadIdx.x < 64) {
      while (__hip_atomic_load(p.lnready + 8, __ATOMIC_RELAXED, __HIP_MEMORY_SCOPE_AGENT) < 2048) __builtin_amdgcn_s_sleep(8);
      __builtin_amdgcn_fence(__ATOMIC_ACQUIRE, "agent");
      asm volatile("s_waitcnt vmcnt(0)" ::: "memory");
    }
    __syncthreads();
  } else {
    gbar(p.gbarw + 48, (int)gridDim.x);
  }
#if STOP_AFTER == 1
  return;
#endif

  phaseB(p, smem, 0, 0, 1 << 30);
#if PROBE_B
  phaseB(p, smem, 1, PROBE_B_LO, PROBE_B_HI);
#endif
  gbar(p.gbarw + 16, (int)gridDim.x);
#if STOP_AFTER == 2
  return;
#endif

  {
    SchedOut S; S.p = &p; S.G = (int)gridDim.x; S.c = (int)blockIdx.x;
    EpiAll E; E.p = &p; E.handoff = (gridDim.x == 256);
    gemm_phase<EpiAll, SchedOut>((LAS unsigned char*)smem, S, E);
  }
  if (gridDim.x == 256) {
    __syncthreads();
    if (threadIdx.x == 0) {
      __builtin_amdgcn_fence(__ATOMIC_RELEASE, "agent");
      if (blockIdx.x < 16) __hip_atomic_fetch_add(p.lnready + 1, 1, __ATOMIC_RELAXED, __HIP_MEMORY_SCOPE_AGENT);
      else __hip_atomic_fetch_add(p.lnready, 8, __ATOMIC_RELAXED, __HIP_MEMORY_SCOPE_AGENT);
    }
    __syncthreads();
    phaseD_handoff(p, smem);
    return;
  }
  gbar(p.gbarw + 4, (int)gridDim.x);

  phaseD(p);
}

extern "C" void kernel_launch(void* const* d_in, const int* in_sizes, int n_in, void* d_out, int out_size, void* d_ws,
                              size_t ws_size, hipStream_t stream) {
  static int grid_blocks = 0;
  if (!grid_blocks) {
    int dev = 0, cus = 0, per_cu = 0;
    (void)hipGetDevice(&dev);
    (void)hipDeviceGetAttribute(&cus, hipDeviceAttributeMultiprocessorCount, dev);
    if (hipFuncSetAttribute((const void*)fwd_megakernel, hipFuncAttributeMaxDynamicSharedMemorySize, SMEM_BYTES) != hipSuccess)
      fprintf(stderr, "hipFuncSetAttribute failed\n");
    (void)hipOccupancyMaxActiveBlocksPerMultiprocessor(&per_cu, (const void*)fwd_megakernel, NTHR, SMEM_BYTES);
    if (per_cu < 1) per_cu = 1;
    if (per_cu > 1) per_cu = 1;
    grid_blocks = cus * per_cu;
  }
  Params p{};
  p.x_prompt = (const float*)d_in[0];  p.x_sample = (const float*)d_in[1];
  p.cache_k = (const float*)d_in[2];   p.cache_v = (const float*)d_in[3];
  p.cache_conv = (const float*)d_in[4]; p.cache_mk = (const float*)d_in[5];
  p.cache_mv = (const float*)d_in[6];  p.mem_prompt = (const float*)d_in[7];
  p.rel_table = (const float*)d_in[8]; p.w_in = (const float*)d_in[9];
  p.w_memkv = (const float*)d_in[10];  p.conv_w = (const float*)d_in[11];
  p.lq1 = (const float*)d_in[12];      p.lk1 = (const float*)d_in[13];
  p.lq2 = (const float*)d_in[14];      p.lk2 = (const float*)d_in[15];
  p.subln_g = (const float*)d_in[16];  p.w_out = (const float*)d_in[17];
  p.ln_g = (const float*)d_in[18];     p.ln_b = (const float*)d_in[19];
  p.out = (float*)d_out;
  unsigned char* ws = (unsigned char*)d_ws;
  size_t off = 0;
  auto take = [&](size_t bytes) { unsigned char* q = ws + off; off += (bytes + 255) & ~(size_t)255; return q; };
  p.counter = (int*)take(256);
  p.gbarw = (int*)take(256);
  p.lnready = (int*)take(256);
  p.Xb = (u16*)take((size_t)NTOK * 2048 * 2);
  p.Mb = (u16*)take((size_t)512 * 2048 * 2);
  p.WinT = (u16*)take((size_t)7168 * 2048 * 2);
  p.WmemT = (u16*)take((size_t)1024 * 2048 * 2);
  p.WoutT = (u16*)take((size_t)2048 * 2048 * 2);
  p.Qb = (u16*)take((size_t)NTOK * 1024 * 2);
  p.Kall = (u16*)take((size_t)(NPROMPT + 32 * SKV) * 1024 * 2);
  p.VTp = (u16*)take((size_t)2048 * SEQ * 2);
  p.VTs = (u16*)take((size_t)32768 * SKV * 2);
  p.Hb = (u16*)take((size_t)NTOK * 512 * 2);
  p.Bb = (u16*)take((size_t)NTOK * 512 * 2);
  p.Cb = (u16*)take((size_t)NTOK * 512 * 2);
  p.MQb = (u16*)take((size_t)NTOK * 512 * 2);
  p.Gb = (u16*)take((size_t)NTOK * 2048 * 2);
  p.MKall = (u16*)take((size_t)34 * 256 * 512 * 2);
  p.MVTall = (u16*)take((size_t)34 * 512 * 256 * 2);
  {
    static const long long exp_sizes[20] = {67108864LL, 1048576, 33554432, 33554432, 32768, 4194304, 4194304, 1048576, 256,
                                            14680064, 2097152, 1536, 64, 64, 64, 64, 128, 4194304, 2048, 2048};
    int bad = -1;
    for (int i = 0; i < 20 && i < n_in; ++i) if ((long long)in_sizes[i] != exp_sizes[i]) { bad = i; break; }
    if (bad < 0 && n_in != 20) bad = 20;
    if (bad < 0 && out_size != 136873984) bad = 21;
    if (bad >= 0) {
      p.mode = 1;
    }
  }
  if (off > ws_size) { fprintf(stderr, "workspace too small: need %zu have %zu\n", off, ws_size); return; }
  (void)hipMemsetAsync(p.gbarw, 0, 256, stream);
  void* args[] = {&p};
  hipError_t e = hipLaunchCooperativeKernel((void*)fwd_megakernel, dim3(grid_blocks), dim3(NTHR), args, SMEM_BYTES, stream);
  if (e != hipSuccess) fprintf(stderr, "cooperative launch failed: %s (grid %d)\n", hipGetErrorString(e), grid_blocks);
}
```
